# Optimizing an MI355X kernel written in HIP

```python
import math
import jax, jax.numpy as jnp
from jax import lax
import numpy as np

D_MODEL = 1024
BATCH = 8
SEQ = 4096
DEPTH = 2
DEC_BATCH = 32
DEC_SEQ = 1
PAST_LEN = 16384
PAGE_SIZE = 128

N_EVEN = (DEPTH + 1) // 2
N_ODD = DEPTH // 2

N_HEADS = 8
HEAD_DIM = 64
KV_HEADS = 2
GROUP = N_HEADS // KV_HEADS
ATTN_WIDTH = N_HEADS * HEAD_DIM
CMP_LEN = 32
CMP_STRIDE = 16
N_SUB = CMP_LEN // CMP_STRIDE
SEL_BLOCK = 64
SEL_RATIO = SEL_BLOCK // CMP_STRIDE
N_SELECT = 16
WINDOW = 512
Q_BLOCK = 64
N_BRANCH = 3
KV_COLS = 2 * KV_HEADS * HEAD_DIM
SCALE = HEAD_DIM ** -0.5
CONV_CH = D_MODEL // 2
CONV_WIDTH = 31
POOL_WINDOWS = (2, 4, 8, 16)
POOL_GROUP = D_MODEL // len(POOL_WINDOWS)
POOL_BUF = max(POOL_WINDOWS) - 1
D_FF = -(-8 * D_MODEL // (3 * 256)) * 256

IN_A = ATTN_WIDTH + N_BRANCH * KV_COLS + N_HEADS * N_BRANCH + 2 * CONV_CH
MIX_A = ATTN_WIDTH + CONV_CH
EPS = 1e-6
BIG = 1e9

kernel_name = 'nsa_conformer_pool_hybrid_step'


def rmsnorm(x, g):
    x32 = x.astype(jnp.float32)
    y = x32 * lax.rsqrt(jnp.mean(x32 * x32, axis=-1, keepdims=True) + EPS)
    return (y * g.astype(jnp.float32)).astype(x.dtype)


def masked_softmax(s, mask):
    s = jnp.where(mask, s, -jnp.inf)
    m = jnp.max(s, axis=-1, keepdims=True)
    m = jnp.where(jnp.isfinite(m), m, 0.0)
    e = jnp.where(mask, jnp.exp(s - m), 0.0)
    return e / jnp.maximum(jnp.sum(e, axis=-1, keepdims=True), jnp.finfo(jnp.float32).tiny)


def swiglu(h, w_gate, w_up, w_down):
    return (jax.nn.silu(h @ w_gate) * (h @ w_up)) @ w_down


def split_even_proj(h, w_in):
    b, t = h.shape[0], h.shape[1]
    z = h @ w_in
    q = z[..., :ATTN_WIDTH].reshape(b, t, KV_HEADS, GROUP, HEAD_DIM)
    off = ATTN_WIDTH
    kv = []
    for _ in range(N_BRANCH):
        kv.append(z[..., off:off + KV_COLS].reshape(b, t, 2, KV_HEADS, HEAD_DIM))
        off += KV_COLS
    gates = z[..., off:off + N_HEADS * N_BRANCH].reshape(b, t, KV_HEADS, GROUP, N_BRANCH)
    off += N_HEADS * N_BRANCH
    u = z[..., off:]
    return q, kv[0], kv[1], kv[2], gates, u


def compress_kv(k, pos, w1, w2):
    b, L = k.shape[0], k.shape[1]
    n_ch = L // CMP_STRIDE
    nb = n_ch - N_SUB + 1
    ch = k[:, :n_ch * CMP_STRIDE].reshape(b, n_ch, CMP_STRIDE, KV_HEADS, HEAD_DIM)
    w1s = w1.reshape(N_SUB, CMP_STRIDE, HEAD_DIM, HEAD_DIM)
    hid = jnp.einsum('ld,lde->e', pos, w1)
    for c in range(N_SUB):
        hid = hid + jnp.einsum('bnlgd,lde->bnge', ch[:, c:c + nb], w1s[c])
    return jnp.einsum('bnge,ef->bngf', jax.nn.gelu(hid), w2)


def compressed_attention(q, t_pos, kcmp, vcmp):
    nb = kcmp.shape[1]
    s = jnp.einsum('bqghd,bngd->bghqn', q, kcmp).astype(jnp.float32) * SCALE
    end = jnp.arange(nb) * CMP_STRIDE + (CMP_LEN - 1)
    p = masked_softmax(s, end[None, :] <= t_pos[:, None])
    o = jnp.einsum('bghqn,bngd->bqghd', p.astype(vcmp.dtype), vcmp)
    return o, p


def select_blocks(p_cmp, t_pos, ns):
    imp = jnp.sum(p_cmp, axis=2)
    nb = imp.shape[-1]
    P = jnp.pad(imp, ((0, 0), (0, 0), (0, 0), (N_SUB - 1, SEL_RATIO * ns - nb)))
    score = 0.0
    for m in range(SEL_RATIO):
        for n in range(N_SUB):
            st = N_SUB - 1 + m - n
            score = score + P[..., st:st + SEL_RATIO * ns:SEL_RATIO]
    blk = jnp.arange(ns)[None, :]
    cur = (t_pos // SEL_BLOCK)[:, None]
    valid = blk * SEL_BLOCK <= t_pos[:, None]
    forced = valid & ((blk == 0) | (blk == cur) | (blk == cur - 1))
    score = jnp.where(forced, BIG, jnp.where(valid, score, -BIG))
    _, idx = lax.top_k(score, min(N_SELECT, ns))
    return idx


def selected_attention(q, t_pos, idx, sel_kv):
    key_pos = idx[..., None] * SEL_BLOCK + jnp.arange(SEL_BLOCK)
    b, g, nq, k, sb = key_pos.shape
    mask = (key_pos <= t_pos[None, None, :, None, None]).reshape(b, g, 1, nq, k * sb)
    s = jnp.einsum('bqghd,bgqkld->bghqkl', q, sel_kv[..., 0, :]).astype(jnp.float32) * SCALE
    p = masked_softmax(s.reshape(b, g, GROUP, nq, k * sb), mask)
    p = p.reshape(b, g, GROUP, nq, k, sb).astype(sel_kv.dtype)
    return jnp.einsum('bghqkl,bgqkld->bqghd', p, sel_kv[..., 1, :])


def window_attention(q, t_pos, slab, key_pos):
    s = jnp.einsum('bqghd,bkgd->bghqk', q, slab[:, :, 0]).astype(jnp.float32) * SCALE
    diff = t_pos[:, None] - key_pos[None, :]
    mask = (diff >= 0) & (diff < WINDOW) & (key_pos[None, :] >= 0)
    p = masked_softmax(s, mask)
    return jnp.einsum('bghqk,bkgd->bqghd', p.astype(slab.dtype), slab[:, :, 1])


def gate_mix(gates, o_c, o_s, o_w):
    g = jax.nn.sigmoid(gates.astype(jnp.float32)).astype(o_c.dtype)
    return g[..., 0:1] * o_c + g[..., 1:2] * o_s + g[..., 2:3] * o_w


def nsa_prompt(q, kv_c, kv_s, kv_w, gates, ck):
    b, t = q.shape[0], q.shape[1]
    kcmp = compress_kv(kv_c[:, :, 0], ck[0], ck[1], ck[2])
    vcmp = compress_kv(kv_c[:, :, 1], ck[3], ck[4], ck[5])
    ns = -(-t // SEL_BLOCK)
    kvs = jnp.pad(kv_s, ((0, 0), (0, ns * SEL_BLOCK - t), (0, 0), (0, 0), (0, 0)))
    kvs = kvs.reshape(b, ns, SEL_BLOCK, 2, KV_HEADS, HEAD_DIM).transpose(0, 4, 1, 2, 3, 5)
    kvw = jnp.pad(kv_w, ((0, 0), (WINDOW, 0), (0, 0), (0, 0), (0, 0)))
    bi = jnp.arange(b)[:, None, None, None]
    gi = jnp.arange(KV_HEADS)[None, :, None, None]

    def block(i):
        q0 = i * Q_BLOCK
        t_pos = q0 + jnp.arange(Q_BLOCK)
        qb = lax.dynamic_slice_in_dim(q, q0, Q_BLOCK, axis=1)
        gb = lax.dynamic_slice_in_dim(gates, q0, Q_BLOCK, axis=1)
        o_c, p_c = compressed_attention(qb, t_pos, kcmp, vcmp)
        idx = select_blocks(p_c, t_pos, ns)
        o_s = selected_attention(qb, t_pos, idx, kvs[bi, gi, idx])
        slab = lax.dynamic_slice_in_dim(kvw, q0, WINDOW + Q_BLOCK, axis=1)
        o_w = window_attention(qb, t_pos, slab, q0 - WINDOW + jnp.arange(WINDOW + Q_BLOCK))
        return gate_mix(gb, o_c, o_s, o_w)

    out = lax.map(block, jnp.arange(t // Q_BLOCK))
    return jnp.moveaxis(out, 0, 1).reshape(b, t, ATTN_WIDTH)


def nsa_sample(q, kv_c, kv_s, kv_w, gates, ck, li, pool_c, pool_s, win_buf, page_table):
    b, s_new = q.shape[0], q.shape[1]
    n_pages = page_table.shape[1]
    past = n_pages * PAGE_SIZE
    past_c = pool_c[li, page_table].reshape(b, past, 2, KV_HEADS, HEAD_DIM)
    full_c = jnp.concatenate([past_c.astype(kv_c.dtype), kv_c], axis=1)
    kcmp = compress_kv(full_c[:, :, 0], ck[0], ck[1], ck[2])
    vcmp = compress_kv(full_c[:, :, 1], ck[3], ck[4], ck[5])
    t_pos = past + jnp.arange(s_new)
    o_c, p_c = compressed_attention(q, t_pos, kcmp, vcmp)
    ns = -(-(past + s_new) // SEL_BLOCK)
    idx = select_blocks(p_c, t_pos, ns)
    key_pos = idx[..., None] * SEL_BLOCK + jnp.arange(SEL_BLOCK)
    bi = jnp.arange(b)[:, None, None, None, None]
    gi = jnp.arange(KV_HEADS)[None, :, None, None, None]
    phys = page_table[bi, jnp.clip(key_pos // PAGE_SIZE, 0, n_pages - 1)]
    from_pool = pool_s[li, phys, key_pos % PAGE_SIZE, :, gi]
    from_new = kv_s[bi, jnp.clip(key_pos - past, 0, s_new - 1), :, gi]
    sel = jnp.where((key_pos < past)[..., None, None], from_pool.astype(kv_s.dtype), from_new)
    o_s = selected_attention(q, t_pos, idx, sel)
    w_buf = win_buf.shape[1]
    slab = jnp.concatenate([win_buf.astype(kv_w.dtype), kv_w], axis=1)
    o_w = window_attention(q, t_pos, slab, past - w_buf + jnp.arange(w_buf + s_new))
    out = gate_mix(gates, o_c, o_s, o_w).reshape(b, s_new, ATTN_WIDTH)
    return out, slab[:, -w_buf:]


def conv_module(u, prev, conv_w, conv_b, ln_g, ln_b):
    a = u[..., :CONV_CH] * jax.nn.sigmoid(u[..., CONV_CH:])
    ext = jnp.concatenate([prev.astype(a.dtype), a], axis=1)
    y = lax.conv_general_dilated(ext, conv_w[:, None, :].astype(a.dtype), window_strides=(1,), padding='VALID',
                                 dimension_numbers=('NWC', 'WIO', 'NWC'), feature_group_count=CONV_CH) + conv_b
    y32 = y.astype(jnp.float32)
    mu = jnp.mean(y32, axis=-1, keepdims=True)
    var = jnp.mean(jnp.square(y32 - mu), axis=-1, keepdims=True)
    yn = (y32 - mu) * lax.rsqrt(var + EPS) * ln_g + ln_b
    return jax.nn.silu(yn).astype(a.dtype), ext[:, -(CONV_WIDTH - 1):]


def pool_module(h, prev, first_pos, pool_w, pool_scale):
    n = h.shape[1]
    ext = jnp.concatenate([prev.astype(h.dtype), h], axis=1)
    cs = jnp.pad(jnp.cumsum(ext.astype(jnp.float32), axis=1), ((0, 0), (1, 0), (0, 0)))
    pos = first_pos + jnp.arange(n)
    hf = h.astype(jnp.float32)
    outs = []
    for gidx, w in enumerate(POOL_WINDOWS):
        c0, c1 = gidx * POOL_GROUP, (gidx + 1) * POOL_GROUP
        win_sum = cs[:, POOL_BUF + 1:, c0:c1] - cs[:, POOL_BUF + 1 - w:POOL_BUF + 1 - w + n, c0:c1]
        cnt = jnp.minimum(w, pos + 1).astype(jnp.float32)
        outs.append(win_sum / cnt[None, :, None] - hf[..., c0:c1])
    z = jnp.stack(outs, axis=2).astype(h.dtype)
    y = jnp.einsum('bngc,gce->bnge', z, pool_w).reshape(h.shape) * pool_scale
    return y, ext[:, -POOL_BUF:]


def setup_inputs(seed: int = 0) -> dict:
    key = jax.random.key(seed)
    ks = jax.random.split(key, 32)
    n_pages = PAST_LEN // PAGE_SIZE
    n_used = DEC_BATCH * n_pages
    n_pool = n_used + n_used // 4
    w_buf = min(WINDOW, PAST_LEN)
    f32 = jnp.float32

    def nrm(k, shape, scale=1.0):
        return jax.random.normal(k, shape, f32) * scale

    page_table = jax.random.permutation(ks[7], n_pool)[:n_used].reshape(DEC_BATCH, n_pages).astype(jnp.int32)
    return {
        'x_prompt': nrm(ks[0], (BATCH, SEQ, D_MODEL)),
        'x_sample': nrm(ks[1], (DEC_BATCH, DEC_SEQ, D_MODEL)),
        'cache_cmp_kv': nrm(ks[2], (N_EVEN, n_pool, PAGE_SIZE, 2, KV_HEADS, HEAD_DIM)),
        'cache_slc_kv': nrm(ks[3], (N_EVEN, n_pool, PAGE_SIZE, 2, KV_HEADS, HEAD_DIM)),
        'state_win_kv': nrm(ks[4], (N_EVEN, DEC_BATCH, w_buf, 2, KV_HEADS, HEAD_DIM)),
        'state_conv': nrm(ks[5], (N_EVEN, DEC_BATCH, CONV_WIDTH - 1, CONV_CH), 0.5),
        'state_pool': nrm(ks[6], (N_ODD, DEC_BATCH, POOL_BUF, D_MODEL)),
        'page_table': page_table,
        'norm_mix': 1.0 + nrm(ks[8], (DEPTH, D_MODEL), 0.05),
        'norm_ffn': 1.0 + nrm(ks[9], (DEPTH, D_MODEL), 0.05),
        'norm_final': 1.0 + nrm(ks[10], (D_MODEL,), 0.05),
        'w_in_a': nrm(ks[11], (N_EVEN, D_MODEL, IN_A), D_MODEL ** -0.5),
        'w_out_a': nrm(ks[12], (N_EVEN, MIX_A, D_MODEL), MIX_A ** -0.5),
        'cmp_pos_k': nrm(ks[13], (N_EVEN, CMP_LEN, HEAD_DIM), 0.5),
        'cmp_w1_k': nrm(ks[14], (N_EVEN, CMP_LEN, HEAD_DIM, HEAD_DIM), (CMP_LEN * HEAD_DIM) ** -0.5),
        'cmp_w2_k': nrm(ks[15], (N_EVEN, HEAD_DIM, HEAD_DIM), HEAD_DIM ** -0.5),
        'cmp_pos_v': nrm(ks[16], (N_EVEN, CMP_LEN, HEAD_DIM), 0.5),
        'cmp_w1_v': nrm(ks[17], (N_EVEN, CMP_LEN, HEAD_DIM, HEAD_DIM), (CMP_LEN * HEAD_DIM) ** -0.5),
        'cmp_w2_v': nrm(ks[18], (N_EVEN, HEAD_DIM, HEAD_DIM), HEAD_DIM ** -0.5),
        'conv_w': nrm(ks[19], (N_EVEN, CONV_WIDTH, CONV_CH), CONV_WIDTH ** -0.5),
        'conv_b': nrm(ks[20], (N_EVEN, CONV_CH), 0.02),
        'conv_ln_g': 1.0 + nrm(ks[21], (N_EVEN, CONV_CH), 0.05),
        'conv_ln_b': nrm(ks[22], (N_EVEN, CONV_CH), 0.02),
        'pool_w': nrm(ks[23], (N_ODD, len(POOL_WINDOWS), POOL_GROUP, POOL_GROUP), POOL_GROUP ** -0.5),
        'pool_scale': 0.5 + nrm(ks[24], (N_ODD, D_MODEL), 0.1),
        'w_ffn_gate': nrm(ks[25], (DEPTH, D_MODEL, D_FF), D_MODEL ** -0.5),
        'w_ffn_up': nrm(ks[26], (DEPTH, D_MODEL, D_FF), D_MODEL ** -0.5),
        'w_ffn_down': nrm(ks[27], (DEPTH, D_FF, D_MODEL), D_FF ** -0.5),
    }


def reference(x_prompt, x_sample, cache_cmp_kv, cache_slc_kv, state_win_kv, state_conv, state_pool, page_table,
              norm_mix, norm_ffn, norm_final, w_in_a, w_out_a, cmp_pos_k, cmp_w1_k, cmp_w2_k, cmp_pos_v, cmp_w1_v,
              cmp_w2_v, conv_w, conv_b, conv_ln_g, conv_ln_b, pool_w, pool_scale, w_ffn_gate, w_ffn_up, w_ffn_down):
    xp, xs = x_prompt, x_sample
    bp, tp = xp.shape[0], xp.shape[1]
    past = page_table.shape[1] * PAGE_SIZE
    cmp_p, cmp_s, slc_p, slc_s, win_p, win_s, conv_p, conv_s, pool_p, pool_s = [], [], [], [], [], [], [], [], [], []
    for l in range(DEPTH):
        hp = rmsnorm(xp, norm_mix[l])
        hs = rmsnorm(xs, norm_mix[l])
        if l % 2 == 0:
            i = l // 2
            ck = (cmp_pos_k[i], cmp_w1_k[i], cmp_w2_k[i], cmp_pos_v[i], cmp_w1_v[i], cmp_w2_v[i])
            cw = (conv_w[i], conv_b[i], conv_ln_g[i], conv_ln_b[i])
            q, kvc, kvs, kvw, g, u = split_even_proj(hp, w_in_a[i])
            a_out = nsa_prompt(q, kvc, kvs, kvw, g, ck)
            c_out, c_st = conv_module(u, jnp.zeros((bp, CONV_WIDTH - 1, CONV_CH), hp.dtype), *cw)
            mp = jnp.concatenate([a_out, c_out], axis=-1) @ w_out_a[i]
            cmp_p.append(kvc)
            slc_p.append(kvs)
            win_p.append(kvw[:, -min(WINDOW, tp):])
            conv_p.append(c_st)
            q, kvc, kvs, kvw, g, u = split_even_proj(hs, w_in_a[i])
            a_out, w_st = nsa_sample(q, kvc, kvs, kvw, g, ck, i, cache_cmp_kv, cache_slc_kv, state_win_kv[i], page_table)
            c_out, c_st = conv_module(u, state_conv[i], *cw)
            ms = jnp.concatenate([a_out, c_out], axis=-1) @ w_out_a[i]
            cmp_s.append(kvc)
            slc_s.append(kvs)
            win_s.append(w_st)
            conv_s.append(c_st)
        else:
            j = l // 2
            mp, p_st = pool_module(hp, jnp.zeros((bp, POOL_BUF, D_MODEL), hp.dtype), 0, pool_w[j], pool_scale[j])
            ms, s_st = pool_module(hs, state_pool[j], past, pool_w[j], pool_scale[j])
            pool_p.append(p_st)
            pool_s.append(s_st)
        xp = xp + mp
        xs = xs + ms
        xp = xp + swiglu(rmsnorm(xp, norm_ffn[l]), w_ffn_gate[l], w_ffn_up[l], w_ffn_down[l])
        xs = xs + swiglu(rmsnorm(xs, norm_ffn[l]), w_ffn_gate[l], w_ffn_up[l], w_ffn_down[l])
    y_prompt = rmsnorm(xp, norm_final)
    y_sample = rmsnorm(xs, norm_final)
    return (y_prompt, y_sample, jnp.stack(cmp_p), jnp.stack(cmp_s), jnp.stack(slc_p), jnp.stack(slc_s),
            jnp.stack(win_p), jnp.stack(win_s), jnp.stack(conv_p), jnp.stack(conv_s),
            jnp.stack(pool_p), jnp.stack(pool_s))
```

```cpp
#include <hip/hip_runtime.h>
#include <cstdio>
#include <cstdint>
#ifndef MK_PER_PHASE
#define MK_PER_PHASE 1
#endif
namespace pg8 {
#define PG8_LAS __attribute__((address_space(3)))
typedef unsigned short bf16_t;
typedef short bf16x8 __attribute__((ext_vector_type(8)));
typedef float f32x4 __attribute__((ext_vector_type(4)));
typedef unsigned u32x4 __attribute__((ext_vector_type(4)));
constexpr int BM = 256, BK = 64, HALF = 128, HTB = HALF * BK * 2  , STAGE_BYTES = 8 * HTB, NXCD = 8, WGM = 8;

__host__ __device__ __forceinline__ int lds_byte(int r, int c) { const int st = (r >> 4) * 2 + (c >> 5), rr = r & 15, cc = c & 31, ob = rr * 64 + cc * 2; return st * 1024 + (ob ^ (((ob >> 9) & 1) << 5)); }
__host__ __device__ __forceinline__ void stage_rc(int b, int& R, int& C) { const int st = b / 1024, sb = b % 1024, swz = sb ^ (((sb >> 9) & 1) << 5); R = (st >> 1) * 16 + swz / 64; C = (st & 1) * 32 + (swz % 64) / 2; }
__host__ __device__ __forceinline__ int perm32(int rho) { const int n = rho >> 4, i = rho & 15; return 8 * (i >> 2) + 4 * n + (i & 3); }

struct Unit { int pm, pn; };
struct Gemm { const bf16_t* A; const bf16_t* Bt; int M, N, K, lda, acol; };

struct StaticOrder {
    int nM, nN, nwg, G, c;
    __host__ __device__ void init(int M, int N, int G_, int c_) { nM = M / BM; nN = N / BM; nwg = nM * nN; G = G_; c = c_; }
    __host__ __device__ bool next(int i, Unit& u) const {
        const long L = (long)i * G + c; if (L >= nwg) return false;
        int wgid = (int)L; { const int q = nwg / NXCD, r = nwg % NXCD, xcd = wgid % NXCD, off = wgid / NXCD; wgid = (xcd < r ? xcd * (q + 1) : r * (q + 1) + (xcd - r) * q) + off; }
        const int nig = WGM * nN, gid = wgid / nig, fm = gid * WGM, gsz = (nM - fm) < WGM ? (nM - fm) : WGM;
        u.pm = fm + ((wgid % nig) % gsz); u.pn = (wgid % nig) / gsz; return true;
    }
    __device__ __forceinline__ void a_ready(const Unit&) const {}
    __device__ __forceinline__ void done(const Unit&) const {}
};
__device__ __forceinline__ unsigned cvt_pk_bf16(float lo, float hi) { unsigned r; asm volatile("v_cvt_pk_bf16_f32 %0, %1, %2" : "=v"(r) : "v"(lo), "v"(hi)); return r; }
template <class Epi, class Sched, bool ALIGN_EPI = false, bool SP2 = false>
__device__ __forceinline__ void gemm_phase(PG8_LAS unsigned char* lds, const Gemm g, const Sched& S, const Epi& E) {
    const int tid = threadIdx.x, wid = __builtin_amdgcn_readfirstlane(tid >> 6), lane = tid & 63, wr = wid >> 2, wc = wid & 3, fr = lane & 15, fq = lane >> 4;
    const int K = g.K, nt = K / BK, lda = g.lda;
    unsigned voffA[2], voffB[2];
#pragma unroll
    for (int i = 0; i < 2; ++i) { int R, C; stage_rc(tid * 16 + i * 8192, R, C); const int Rb = Epi::PERM ? ((R & ~31) + perm32(R & 31)) : R;
        voffA[i] = (unsigned)(R * lda + C) * 2u; voffB[i] = (unsigned)(Rb * K + C) * 2u; }
    const size_t kstep = (size_t)(BK * 2);
    const size_t hstepA = (size_t)HALF * lda * 2, hstepB = (size_t)HALF * K * 2;
    const size_t tstepA = 2 * hstepA, tstepB = 2 * hstepB; const size_t acolb = (size_t)g.acol * 2;
    const unsigned ldsw = (unsigned)wid * 1024u;
    const int aoff = lds_byte(wr * 64 + fr, fq * 8), boff = lds_byte(wc * 32 + fr, fq * 8);
#define PG8_SA(b, h) (((b) * 2 + (h)) * HTB)
#define PG8_SB(b, h) ((4 + (b) * 2 + (h)) * HTB)
#define PG8_STAGE(bufoff, gbase, voff) do { _Pragma("unroll") for (int _i = 0; _i < 2; ++_i) \
        __builtin_amdgcn_global_load_lds((const unsigned*)((const char*)(gbase) + (voff)[_i]), (PG8_LAS unsigned*)(lds + (bufoff) + ldsw + _i * 8192), 16, 0, 0); } while (0)
#define PG8_LDA(dst, b, h) do { _Pragma("unroll") for (int m = 0; m < 4; ++m) _Pragma("unroll") for (int k = 0; k < 2; ++k) dst[m][k] = *(const PG8_LAS bf16x8*)(lds + PG8_SA(b, h) + aoff + m * 2048 + k * 1024); } while (0)
#define PG8_LDB(dst, b, h) do { _Pragma("unroll") for (int n = 0; n < 2; ++n) _Pragma("unroll") for (int k = 0; k < 2; ++k) dst[n][k] = *(const PG8_LAS bf16x8*)(lds + PG8_SB(b, h) + boff + n * 2048 + k * 1024); } while (0)
#define PG8_MMA(ai, bj, At, Bt) do { __builtin_amdgcn_s_setprio(1); _Pragma("unroll") for (int m = 0; m < 4; ++m) _Pragma("unroll") for (int n = 0; n < 2; ++n) _Pragma("unroll") for (int k = 0; k < 2; ++k) \
        acc[ai][bj][m][n] = __builtin_amdgcn_mfma_f32_16x16x32_bf16(Bt[n][k], At[m][k], acc[ai][bj][m][n], 0, 0, 0); __builtin_amdgcn_s_setprio(0); } while (0)
#define PG8_WAIT_V(n) asm volatile("s_waitcnt vmcnt(" #n ")" ::: "memory")
#define PG8_WAIT_L(n) asm volatile("s_waitcnt lgkmcnt(" #n ")" ::: "memory")
#define PG8_BAR __builtin_amdgcn_s_barrier()
#define PG8_SCHED __builtin_amdgcn_sched_barrier(0)
    Unit cur, nxt; int ui = 0;
    if (!S.next(0, cur)) return;
    f32x4 acc[2][2][4][2];
#pragma unroll
    for (int a = 0; a < 2; ++a)
#pragma unroll
        for (int b = 0; b < 2; ++b)
#pragma unroll
            for (int m = 0; m < 4; ++m)
#pragma unroll
                for (int n = 0; n < 2; ++n) acc[a][b][m][n] = (f32x4){0.f, 0.f, 0.f, 0.f};
    bf16x8 At[4][2], B0[2][2], B1[2][2];
    const char* cA = (const char*)g.A + (size_t)cur.pm * tstepA + (size_t)cur.pn * acolb; const char* cB = (const char*)g.Bt + (size_t)cur.pn * tstepB;
    S.a_ready(cur);
    if constexpr (SP2) {
        PG8_STAGE(PG8_SB(0, 0), cB, voffB); PG8_STAGE(PG8_SB(0, 1), cB + hstepB, voffB); PG8_STAGE(PG8_SA(0, 0), cA, voffA); PG8_STAGE(PG8_SA(0, 1), cA + hstepA, voffA);
        if (wr == 1) PG8_BAR;
        PG8_WAIT_V(2); PG8_BAR;
        PG8_STAGE(PG8_SB(1, 0), cB + kstep, voffB); PG8_STAGE(PG8_SA(1, 0), cA + kstep, voffA); PG8_STAGE(PG8_SB(1, 1), cB + hstepB + kstep, voffB);
        PG8_WAIT_V(6); PG8_BAR;
    } else {
        PG8_STAGE(PG8_SB(0, 0), cB, voffB); PG8_STAGE(PG8_SA(0, 0), cA, voffA); PG8_STAGE(PG8_SB(0, 1), cB + hstepB, voffB); PG8_STAGE(PG8_SA(0, 1), cA + hstepA, voffA);
        if (wr == 1) PG8_BAR;
        PG8_WAIT_V(4); PG8_BAR;
        PG8_STAGE(PG8_SB(1, 0), cB + kstep, voffB); PG8_STAGE(PG8_SA(1, 0), cA + kstep, voffA); PG8_STAGE(PG8_SB(1, 1), cB + hstepB + kstep, voffB);
        PG8_WAIT_V(6); PG8_BAR;
    }
    for (;;) {
        const bool has_next = S.next(ui + 1, nxt);
        const char* nA = has_next ? (const char*)g.A + (size_t)nxt.pm * tstepA + (size_t)nxt.pn * acolb : cA; const char* nB = has_next ? (const char*)g.Bt + (size_t)nxt.pn * tstepB : cB;
        for (int t = 0; t < nt; t += 2) {
            const bool last = (t == nt - 2);
            const char* a1 = cA + (size_t)(t + 1) * kstep;
            const char* a2 = last ? nA : cA + (size_t)(t + 2) * kstep; const char* b2 = last ? nB : cB + (size_t)(t + 2) * kstep;
            const char* a3 = a2 + kstep; const char* b3 = b2 + kstep;
            if (last && has_next) S.a_ready(nxt);
            if constexpr (SP2) {
            PG8_LDB(B0, 0, 0); PG8_LDB(B1, 0, 1); PG8_SCHED; PG8_LDA(At, 0, 0); PG8_STAGE(PG8_SA(1, 1), a1 + hstepA, voffA);
            PG8_WAIT_V(8); PG8_WAIT_L(0); PG8_BAR; PG8_MMA(0, 0, At, B0); PG8_MMA(0, 1, At, B1); PG8_BAR; PG8_SCHED;
            PG8_LDA(At, 0, 1); PG8_STAGE(PG8_SB(0, 0), b2, voffB); PG8_STAGE(PG8_SB(0, 1), b2 + hstepB, voffB); PG8_STAGE(PG8_SA(0, 0), a2, voffA);
            PG8_WAIT_V(8); PG8_WAIT_L(0); PG8_BAR; PG8_MMA(1, 0, At, B0); PG8_MMA(1, 1, At, B1); PG8_BAR; PG8_SCHED;
            PG8_LDB(B0, 1, 0); PG8_LDB(B1, 1, 1); PG8_SCHED; PG8_LDA(At, 1, 0); PG8_STAGE(PG8_SA(0, 1), a2 + hstepA, voffA);
            PG8_WAIT_V(8); PG8_WAIT_L(0); PG8_BAR; PG8_MMA(0, 0, At, B0); PG8_MMA(0, 1, At, B1); PG8_BAR; PG8_SCHED;
            PG8_LDA(At, 1, 1); PG8_STAGE(PG8_SB(1, 0), b3, voffB); PG8_STAGE(PG8_SB(1, 1), b3 + hstepB, voffB); PG8_STAGE(PG8_SA(1, 0), a3, voffA);
            PG8_WAIT_V(8); PG8_WAIT_L(0); PG8_BAR; PG8_MMA(1, 0, At, B0); PG8_MMA(1, 1, At, B1); PG8_BAR; PG8_SCHED;
            } else {
            PG8_LDB(B0, 0, 0); PG8_SCHED; PG8_LDA(At, 0, 0); PG8_STAGE(PG8_SA(1, 1), a1 + hstepA, voffA);
            PG8_WAIT_L(8); PG8_BAR; PG8_WAIT_L(0); PG8_MMA(0, 0, At, B0); PG8_BAR; PG8_SCHED;
            PG8_LDB(B1, 0, 1); PG8_STAGE(PG8_SB(0, 0), b2, voffB);
            PG8_BAR; PG8_WAIT_L(0); PG8_MMA(0, 1, At, B1); PG8_BAR;
            PG8_LDA(At, 0, 1); PG8_STAGE(PG8_SA(0, 0), a2, voffA);
            PG8_BAR; PG8_WAIT_L(0); PG8_MMA(1, 0, At, B0); PG8_BAR; PG8_SCHED;
            PG8_STAGE(PG8_SB(0, 1), b2 + hstepB, voffB);
            PG8_WAIT_V(6); PG8_BAR; PG8_MMA(1, 1, At, B1); PG8_BAR;
            PG8_LDB(B0, 1, 0); PG8_SCHED; PG8_LDA(At, 1, 0); PG8_STAGE(PG8_SA(0, 1), a2 + hstepA, voffA);
            PG8_WAIT_L(8); PG8_BAR; PG8_WAIT_L(0); PG8_MMA(0, 0, At, B0); PG8_BAR; PG8_SCHED;
            PG8_LDB(B1, 1, 1); PG8_STAGE(PG8_SB(1, 0), b3, voffB);
            PG8_BAR; PG8_WAIT_L(0); PG8_MMA(0, 1, At, B1); PG8_BAR;
            PG8_LDA(At, 1, 1); PG8_STAGE(PG8_SA(1, 0), a3, voffA);
            PG8_BAR; PG8_WAIT_L(0); PG8_MMA(1, 0, At, B0); PG8_BAR; PG8_SCHED;
            PG8_STAGE(PG8_SB(1, 1), b3 + hstepB, voffB);
            PG8_WAIT_V(6); PG8_BAR; PG8_MMA(1, 1, At, B1); PG8_BAR;
            }
        }
        if constexpr (ALIGN_EPI) { if (wr == 0) PG8_BAR; }
        if constexpr (!Epi::AFTER_DRAIN) { E(acc, cur, wr, wc, fr, fq); S.done(cur); }
        if (!has_next) break;
#pragma unroll
        for (int a = 0; a < 2; ++a)
#pragma unroll
            for (int b = 0; b < 2; ++b)
#pragma unroll
                for (int m = 0; m < 4; ++m)
#pragma unroll
                    for (int n = 0; n < 2; ++n) acc[a][b][m][n] = (f32x4){0.f, 0.f, 0.f, 0.f};
        cur = nxt; cA = nA; cB = nB; ++ui;
        if constexpr (ALIGN_EPI) { if (wr == 1) PG8_BAR; }
    }
    PG8_WAIT_V(0);
    if constexpr (!ALIGN_EPI) { if (wr == 0) PG8_BAR; }
    PG8_BAR;
    if constexpr (Epi::AFTER_DRAIN) { E.fused(acc, cur, wr, wc, fr, fq, lds, wid, lane); S.done(cur); }
#undef PG8_SA
#undef PG8_SB
#undef PG8_STAGE
#undef PG8_LDA
#undef PG8_LDB
#undef PG8_MMA
#undef PG8_WAIT_V
#undef PG8_WAIT_L
#undef PG8_BAR
#undef PG8_SCHED
}
}

constexpr int NWAVES = 8;
constexpr int DM = 1024, SEQ = 4096, NB = 8, MP = NB * SEQ;
constexpr int SB = 32, PAST = 16384, NPAGE = 128, PAGE = 128;
constexpr int IN_A = 2328, NIN = 2560, FF = 2816, NGU = 2 * FF;
constexpr int CONVW = 31, CCH = 512, POOLB = 15;
constexpr float EPS = 1e-6f;
constexpr float LOG2E = 1.4426950408889634f;
constexpr float QSCALE = 0.125f * LOG2E;
constexpr int NCH_S = 1024, NBLK_S = 1023, NCH_P = 256, NBLK_P = 255;
constexpr size_t O_Y = 0, O_YS = 33554432, O_CMP_P = 33587200, O_CMP_S = 41975808, O_SLC_P = 41984000, O_SLC_S = 50372608,
                 O_WIN_P = 50380800, O_WIN_S = 51429376, O_CONV_P = 55623680, O_CONV_S = 55746560, O_POOL_P = 56238080, O_POOL_S = 56360960, O_END = 56852480;
constexpr size_t MiB = 1u << 20;
constexpr size_t WS_CTL = 0, CTL_ZERO_BYTES = 2 * MiB;
constexpr size_t WS_ROWSS = 1 * MiB;
constexpr int RS_STRIDE = MP + SB;
constexpr size_t WS_POST = 2 * MiB;
constexpr size_t WS_WIN_T = 4 * MiB, WS_WOUT_T = 10 * MiB, WS_WGU_T = 12 * MiB, WS_WD_T = 34 * MiB, WS_POOL_T = 46 * MiB, WS_W1F = 47 * MiB, WS_W2T = 48 * MiB;
constexpr size_t WGU_BYTES = (size_t)NGU * DM * 2, WD_BYTES = (size_t)DM * FF * 2;
constexpr size_t WS_HS0 = 49 * MiB, WS_ZS = WS_HS0 + 65536, WS_MIXS = WS_ZS + 327680, WS_XRS = WS_MIXS + 65536, WS_XBS = WS_XRS + 131072, WS_HFS = WS_XBS + 65536, WS_ZPS = WS_HFS + 180224;
constexpr size_t WS_KCMP_P = 52 * MiB, WS_VCMP_P = 53 * MiB, WS_KCMP_S = 54 * MiB, WS_VCMP_S = 70 * MiB;
constexpr size_t WS_H0 = 96 * MiB, WS_Q = 160 * MiB, WS_KS = 192 * MiB, WS_KW = 208 * MiB, WS_GATES = 224 * MiB, WS_AGLU = 232 * MiB, WS_MIX = 264 * MiB,
                 WS_XR = 328 * MiB, WS_XB = 456 * MiB, WS_HF = 520 * MiB, WS_Z = 696 * MiB, WS_END = 768 * MiB;
static_assert(WS_ZPS + 65536 <= WS_KCMP_P && WS_WGU_T + 2 * WGU_BYTES <= WS_WD_T && WS_WD_T + 2 * WD_BYTES <= WS_POOL_T, "ws map");
constexpr int CW_TMO = 0, CW_BAR = 4096;
constexpr int RING_BYTES = 131072, LDSCTL_OFF = RING_BYTES, MISC_OFF = LDSCTL_OFF + 320, LDS_BYTES = 147456;

#define GAS __attribute__((address_space(1)))
#define LAS __attribute__((address_space(3)))
typedef unsigned short bf16;
typedef unsigned v4u __attribute__((ext_vector_type(4)));
typedef float f32x4 __attribute__((ext_vector_type(4)));
typedef short bf16x8 __attribute__((ext_vector_type(8)));
typedef GAS unsigned gu32;
typedef GAS unsigned long long gu64;
#define RLX_AGENT __ATOMIC_RELAXED, __HIP_MEMORY_SCOPE_AGENT
#define LDS_WAIT() asm volatile("s_waitcnt lgkmcnt(0)" ::: "memory")
#define VM_WAIT() asm volatile("s_waitcnt vmcnt(0)" ::: "memory")
__device__ __forceinline__ unsigned long long rt() { return __builtin_amdgcn_s_memrealtime(); }
__device__ __forceinline__ unsigned f2bf(float f) { unsigned u = __builtin_bit_cast(unsigned, f); return (u + 0x7fffu + ((u >> 16) & 1u)) >> 16; }
__device__ __forceinline__ unsigned pk2(float lo, float hi) { return f2bf(lo) | (f2bf(hi) << 16); }

#define XB_TMO      128
#define XB_XCNT(j)  (256  + 64 * (j))
#define XB_XSUB(j)  (1280 + 64 * (j))
#define XB_XGEN(j)  (2304 + 64 * (j))
#define XB_TOP      3328
#define XB_TOPGEN   3392
#define XCD_BAR_WORDS 3456
#define XB_SPIN_CAP (1u << 18)

__device__ __forceinline__ unsigned xb_ld(unsigned* p)              { return __hip_atomic_load(p, __ATOMIC_RELAXED, __HIP_MEMORY_SCOPE_AGENT); }
__device__ __forceinline__ unsigned xb_add(unsigned* p, unsigned v) { return __hip_atomic_fetch_add(p, v, __ATOMIC_RELAXED, __HIP_MEMORY_SCOPE_AGENT); }
__device__ __forceinline__ unsigned xb_xcc_id() { return (unsigned)__builtin_amdgcn_s_getreg((3 << 11) | 20) & 0xFu; }
#define XB_SPIN(cond, bar) do { unsigned _sp = 0; while (cond) { __builtin_amdgcn_s_sleep(1); \
    if ((++_sp & 255u) == 0u) { if (xb_ld(&(bar)[XB_TMO])) break; if (_sp > XB_SPIN_CAP) { atomicAdd(&(bar)[XB_TMO], 1u); break; } } } } while (0)

struct XcdBarrier {
    unsigned* bar; unsigned x;
    volatile LAS unsigned* st;
};

__device__ __forceinline__ XcdBarrier xcd_barrier_post(unsigned* bar, volatile LAS unsigned* st) {
    XcdBarrier b; b.bar = bar; b.x = xb_xcc_id(); b.st = st;
    if (threadIdx.x == 0) (void)xb_add(&bar[XB_XCNT(b.x)], 1u);
    return b;
}
__device__ __forceinline__ void xcd_barrier_complete(unsigned* bar, unsigned x, unsigned& nloc, unsigned& nx) {
    const unsigned G = gridDim.x * gridDim.y * gridDim.z;
    unsigned sum, cnt, mine, sp = 0u;
    for (;;) {
        sum = 0u; cnt = 0u; mine = 0u;
#pragma unroll
        for (unsigned j = 0; j < 16; ++j) { const unsigned c = xb_ld(&bar[XB_XCNT(j)]); sum += c; cnt += (c > 0u) ? 1u : 0u; mine = (j == x) ? c : mine; }
        if (sum == G) break;
        __builtin_amdgcn_s_sleep(1);
        if ((++sp & 255u) == 0u) { if (xb_ld(&bar[XB_TMO])) break; if (sp > XB_SPIN_CAP) { atomicAdd(&bar[XB_TMO], 1u); break; } }
    }
    nloc = mine > 0u ? mine : 1u; nx = cnt > 0u ? cnt : 1u;
}

__device__ __forceinline__ void xcd_barrier(const XcdBarrier& b) {
    asm volatile("s_waitcnt vmcnt(0)" ::: "memory");
    __syncthreads();
    if (threadIdx.x == 0) {
        unsigned* bar = b.bar;
        __builtin_amdgcn_s_waitcnt(0);
        unsigned nloc = b.st[0], nx = b.st[1];
        if (nloc == 0u) { xcd_barrier_complete(bar, b.x, nloc, nx); b.st[0] = nloc; b.st[1] = nx; }
        const unsigned old = xb_add(&bar[XB_XSUB(b.x)], 1u);
        const unsigned gen = old / nloc;
        if (old + 1u == (gen + 1u) * nloc) {
            __builtin_amdgcn_fence(__ATOMIC_RELEASE, "agent");
            asm volatile("s_waitcnt vmcnt(0)" ::: "memory");
            const unsigned og = xb_add(&bar[XB_TOP], 1u);
            const unsigned tg = og / nx;
            if (og + 1u == (tg + 1u) * nx) xb_add(&bar[XB_TOPGEN], 1u);
            else XB_SPIN(xb_ld(&bar[XB_TOPGEN]) == tg, bar);
            __builtin_amdgcn_fence(__ATOMIC_ACQUIRE, "agent");
            xb_add(&bar[XB_XGEN(b.x)], 1u);
            asm volatile("s_waitcnt vmcnt(0)" ::: "memory");
        } else {
            XB_SPIN(xb_ld(&bar[XB_XGEN(b.x)]) == gen, bar);
            __builtin_amdgcn_fence(__ATOMIC_ACQUIRE, "agent");
            asm volatile("s_waitcnt vmcnt(0)" ::: "memory");
        }
    }
    __syncthreads();
}

typedef float f32x16 __attribute__((ext_vector_type(16)));
typedef float f32x2 __attribute__((ext_vector_type(2)));
typedef short s16x4 __attribute__((ext_vector_type(4)));
typedef unsigned u32x2 __attribute__((ext_vector_type(2)));
__device__ __forceinline__ float bf2f(unsigned short u) { return __builtin_bit_cast(float, (unsigned)u << 16); }
__device__ __forceinline__ float bflo(unsigned w) { return __builtin_bit_cast(float, w << 16); }
__device__ __forceinline__ float bfhi(unsigned w) { return __builtin_bit_cast(float, w & 0xffff0000u); }
__device__ __forceinline__ float fexp2(float x) { return __builtin_amdgcn_exp2f(x); }
__device__ __forceinline__ float frcp(float x) { return __builtin_amdgcn_rcpf(x); }
__device__ __forceinline__ float sigmoidf_(float x) { return frcp(1.0f + fexp2(-x * LOG2E)); }
__device__ __forceinline__ float wave_sum(float v) {
#pragma unroll
    for (int o = 1; o < 64; o <<= 1) v += __shfl_xor(v, o);
    return v;
}
__device__ __forceinline__ float wave_max(float v) {
#pragma unroll
    for (int o = 1; o < 64; o <<= 1) v = fmaxf(v, __shfl_xor(v, o));
    return v;
}
__device__ __forceinline__ void atomic_addf(float* p, float v) { __hip_atomic_fetch_add(p, v, __ATOMIC_RELAXED, __HIP_MEMORY_SCOPE_AGENT); }
__device__ __forceinline__ v4u pack8(const f32x4 a, const f32x4 b) { v4u w; w.x = pg8::cvt_pk_bf16(a[0], a[1]); w.y = pg8::cvt_pk_bf16(a[2], a[3]); w.z = pg8::cvt_pk_bf16(b[0], b[1]); w.w = pg8::cvt_pk_bf16(b[2], b[3]); return w; }

struct Args { const float* in[28]; float* out; unsigned char* ws; int ph_lo, ph_hi; };
struct Frame {
    LAS unsigned char* lds; volatile LAS unsigned* MISC; gu32* ctl;
    int tid, lane, wave, vcu, G;
    const float* const* in; float* out; unsigned char* ws;
};

using pg8::Unit;
struct EpiInProj {
    static constexpr bool PERM = true, AFTER_DRAIN = false;
    bf16* Q; bf16* KS; bf16* KW; bf16* AGLU; float* GATES; float* out;
    __device__ __forceinline__ void operator()(const f32x4 (&acc)[2][2][4][2], const Unit& u, int wr, int wc, int fr, int fq) const {
        const int row0 = u.pm * 256 + wr * 64 + fr, cw = wc * 32 + 8 * fq, pn = u.pn;
        if (pn < 2) {
#pragma unroll
            for (int ai = 0; ai < 2; ++ai)
#pragma unroll
                for (int m = 0; m < 4; ++m) { const int row = row0 + ai * 128 + m * 16;
#pragma unroll
                    for (int bj = 0; bj < 2; ++bj) *(GAS v4u*)(Q + (size_t)row * 512 + pn * 256 + bj * 128 + cw) = pack8(acc[ai][bj][m][0] * QSCALE, acc[ai][bj][m][1] * QSCALE); }
        } else if (pn == 2 || pn == 3) {
            float* o = out + (pn == 2 ? O_CMP_P : O_SLC_P);
#pragma unroll
            for (int ai = 0; ai < 2; ++ai)
#pragma unroll
                for (int m = 0; m < 4; ++m) { const int row = row0 + ai * 128 + m * 16;
#pragma unroll
                    for (int bj = 0; bj < 2; ++bj) { const size_t off = (size_t)row * 256 + bj * 128 + cw;
                        *(GAS f32x4*)(o + off) = acc[ai][bj][m][0]; *(GAS f32x4*)(o + off + 4) = acc[ai][bj][m][1];
                        if (pn == 3) *(GAS v4u*)(KS + off) = pack8(acc[ai][bj][m][0], acc[ai][bj][m][1]); } }
        } else if (pn == 4) {
#pragma unroll
            for (int ai = 0; ai < 2; ++ai)
#pragma unroll
                for (int m = 0; m < 4; ++m) { const int row = row0 + ai * 128 + m * 16; const int t = row & (SEQ - 1), b = row >> 12;
#pragma unroll
                    for (int bj = 0; bj < 2; ++bj) { const size_t off = (size_t)row * 256 + bj * 128 + cw;
                        *(GAS v4u*)(KW + off) = pack8(acc[ai][bj][m][0], acc[ai][bj][m][1]);
                        if (t >= SEQ - 512) { float* o = out + O_WIN_P + ((size_t)(b * 512 + t - (SEQ - 512)) * 256 + bj * 128 + cw);
                            *(GAS f32x4*)(o) = acc[ai][bj][m][0]; *(GAS f32x4*)(o + 4) = acc[ai][bj][m][1]; } } }
        } else if (pn < 9) {
            const int j = pn - 5;
#pragma unroll
            for (int ai = 0; ai < 2; ++ai)
#pragma unroll
                for (int m = 0; m < 4; ++m) { const int row = row0 + ai * 128 + m * 16; const int t = row & (SEQ - 1), b = row >> 12;
                    f32x4 a0, a1;
#pragma unroll
                    for (int e = 0; e < 4; ++e) { a0[e] = acc[ai][0][m][0][e] * sigmoidf_(acc[ai][1][m][0][e]); a1[e] = acc[ai][0][m][1][e] * sigmoidf_(acc[ai][1][m][1][e]); }
                    const int col = j * 128 + cw;
                    *(GAS v4u*)(AGLU + (size_t)row * 512 + col) = pack8(a0, a1);
                    if (t >= SEQ - (CONVW - 1)) { float* o = out + O_CONV_P + ((size_t)(b * (CONVW - 1) + t - (SEQ - (CONVW - 1))) * CCH + col);
                        *(GAS f32x4*)(o) = a0; *(GAS f32x4*)(o + 4) = a1; } }
        } else {
            if (wc == 0) {
#pragma unroll
                for (int ai = 0; ai < 2; ++ai)
#pragma unroll
                    for (int m = 0; m < 4; ++m) { const int row = row0 + ai * 128 + m * 16; float* o = GATES + (size_t)row * 32 + 8 * fq;
                        *(GAS f32x4*)(o) = acc[ai][0][m][0]; *(GAS f32x4*)(o + 4) = acc[ai][0][m][1]; }
            }
        }
    }
};
template <bool FROM_X, bool SCALE, bool WXB> struct EpiRes {
    static constexpr bool PERM = true, AFTER_DRAIN = false;
    const float* xin; float* XR; bf16* XB; const float* scale; float* rowss;
    __device__ __forceinline__ void operator()(const f32x4 (&acc)[2][2][4][2], const Unit& u, int wr, int wc, int fr, int fq) const {
        const int row0 = u.pm * 256 + wr * 64 + fr, col0 = u.pn * 256 + wc * 32 + 8 * fq;
        f32x4 sc[2][2];
        if (SCALE) {
#pragma unroll
            for (int bj = 0; bj < 2; ++bj) { sc[bj][0] = *(const GAS f32x4*)(scale + col0 + bj * 128); sc[bj][1] = *(const GAS f32x4*)(scale + col0 + bj * 128 + 4); }
        }
#pragma unroll
        for (int ai = 0; ai < 2; ++ai)
#pragma unroll
            for (int m = 0; m < 4; ++m) { const int row = row0 + ai * 128 + m * 16; float ss = 0.f;
#pragma unroll
                for (int bj = 0; bj < 2; ++bj) { const size_t off = (size_t)row * DM + col0 + bj * 128;
                    const float* base = FROM_X ? xin : XR;
                    f32x4 v0 = *(const GAS f32x4*)(base + off), v1 = *(const GAS f32x4*)(base + off + 4);
                    if (SCALE) { v0 += acc[ai][bj][m][0] * sc[bj][0]; v1 += acc[ai][bj][m][1] * sc[bj][1]; } else { v0 += acc[ai][bj][m][0]; v1 += acc[ai][bj][m][1]; }
                    *(GAS f32x4*)(XR + off) = v0; *(GAS f32x4*)(XR + off + 4) = v1;
                    if (WXB) *(GAS v4u*)(XB + off) = pack8(v0, v1);
                    ss += (v0[0] * v0[0] + v0[1] * v0[1]) + (v0[2] * v0[2] + v0[3] * v0[3]) + (v1[0] * v1[0] + v1[1] * v1[1]) + (v1[2] * v1[2] + v1[3] * v1[3]); }
                ss += __shfl_xor(ss, 16); ss += __shfl_xor(ss, 32);
                if (fq == 0) atomic_addf(rowss + row, ss); }
    }
};
struct EpiGateUp {
    static constexpr bool PERM = true, AFTER_DRAIN = false;
    bf16* HF; const float* rowss;
    __device__ __forceinline__ void operator()(const f32x4 (&acc)[2][2][4][2], const Unit& u, int wr, int wc, int fr, int fq) const {
        const int row0 = u.pm * 256 + wr * 64 + fr, col = u.pn * 128 + wc * 32 + 8 * fq;
#pragma unroll
        for (int ai = 0; ai < 2; ++ai)
#pragma unroll
            for (int m = 0; m < 4; ++m) { const int row = row0 + ai * 128 + m * 16;
                const float rstd = __builtin_amdgcn_rsqf(*(const GAS float*)(rowss + row) * (1.0f / DM) + EPS);
                f32x4 h0, h1;
#pragma unroll
                for (int e = 0; e < 4; ++e) { const float g0 = acc[ai][0][m][0][e] * rstd, u0 = acc[ai][1][m][0][e] * rstd, g1 = acc[ai][0][m][1][e] * rstd, u1 = acc[ai][1][m][1][e] * rstd;
                    h0[e] = g0 * sigmoidf_(g0) * u0; h1[e] = g1 * sigmoidf_(g1) * u1; }
                *(GAS v4u*)(HF + (size_t)row * FF + col) = pack8(h0, h1); }
    }
};

__device__ __forceinline__ int map_in(int n) {
    if (n < 1280) return n;
    if (n < 1304) return 2304 + (n - 1280);
    const int uu = n - 1304, half = uu >> 9, c = uu & 511;
    return 1280 + (c >> 7) * 256 + half * 128 + (c & 127);
}
__device__ __forceinline__ void tr_item(const float* W, int K, int N, bf16* WT, int mode, const float* gain, LAS float* scr, int item, int lane) {
    const int nblk = (N + 31) / 32, kb = item / nblk, nb = item % nblk, k0 = 64 * kb, n0 = 32 * nb;
    const int nn = n0 + (lane & 31);
#pragma unroll 8
    for (int i = 0; i < 32; ++i) { const int kk = 2 * i + (lane >> 5); float v = 0.f; if (nn < N) { v = W[(size_t)(k0 + kk) * N + nn]; if (gain) v *= gain[k0 + kk]; } scr[kk * 33 + (lane & 31)] = v; }
    LDS_WAIT(); asm volatile("" ::: "memory");
    const int c = lane & 7;
#pragma unroll
    for (int j = 0; j < 4; ++j) { const int nl = (lane >> 3) + 8 * j, n = n0 + nl; const LAS float* s = scr + (8 * c) * 33 + nl;
        v4u o; o.x = pk2(s[0 * 33], s[1 * 33]); o.y = pk2(s[2 * 33], s[3 * 33]); o.z = pk2(s[4 * 33], s[5 * 33]); o.w = pk2(s[6 * 33], s[7 * 33]);
        if (n < N) { int r = n; if (mode == 1) r = map_in(n); else if (mode == 2) r = 256 * (n >> 7) + (n & 127); else if (mode == 3) r = 256 * (n >> 7) + 128 + (n & 127);
            *(GAS v4u*)(WT + (size_t)r * K + k0 + 8 * c) = o; } }
    LDS_WAIT(); asm volatile("" ::: "memory");
}
__device__ __forceinline__ void rms_row_to_bf16(const float* xrow, const float* gain, bf16* orow, int lane) {
    const GAS f32x4* xr = (const GAS f32x4*)xrow + lane; const GAS f32x4* gr = (const GAS f32x4*)gain + lane;
    f32x4 v[4]; float s = 0.f;
#pragma unroll
    for (int j = 0; j < 4; ++j) { v[j] = xr[64 * j]; s += (v[j].x * v[j].x + v[j].y * v[j].y) + (v[j].z * v[j].z + v[j].w * v[j].w); }
    const float rstd = 1.0f / sqrtf(wave_sum(s) * (1.0f / DM) + EPS);
    GAS unsigned long long* o8 = (GAS unsigned long long*)orow + lane;
#pragma unroll
    for (int j = 0; j < 4; ++j) { const f32x4 g = gr[64 * j];
        o8[64 * j] = (unsigned long long)pk2(v[j].x * rstd * g.x, v[j].y * rstd * g.y) | ((unsigned long long)pk2(v[j].z * rstd * g.z, v[j].w * rstd * g.w) << 32); }
}
__device__ __forceinline__ void p0_prologue(const Args& A, LAS unsigned char* lds, int vcu, int G, int tid) {
    const int lane = tid & 63, wave = tid >> 6;
    unsigned char* ws = A.ws;
    LAS float* scr = (LAS float*)(lds + wave * 16384);
    const int gw = vcu * NWAVES + wave, NGW = G * NWAVES;
    constexpr int I_IN = 16 * 73, I_OUT = 16 * 32, I_G = 16 * 88, I_D = 44 * 32, I_POOL = 4 * 8, I_W2 = 2;
    constexpr int NITEMS = I_IN + I_OUT + 4 * I_G + 2 * I_D + 4 * I_POOL + 2 * I_W2;
    for (int it = gw; it < NITEMS; it += NGW) {
        int r = it;
        if (r < I_IN) { tr_item(A.in[11], DM, IN_A, (bf16*)(ws + WS_WIN_T), 1, nullptr, scr, r, lane); continue; } r -= I_IN;
        if (r < I_OUT) { tr_item(A.in[12], DM, DM, (bf16*)(ws + WS_WOUT_T), 0, nullptr, scr, r, lane); continue; } r -= I_OUT;
        bool done = false;
        for (int l = 0; l < 2 && !done; ++l) {
            if (r < I_G) { tr_item(A.in[25] + (size_t)l * DM * FF, DM, FF, (bf16*)(ws + WS_WGU_T + l * WGU_BYTES), 2, A.in[9] + l * DM, scr, r, lane); done = true; break; } r -= I_G;
            if (r < I_G) { tr_item(A.in[26] + (size_t)l * DM * FF, DM, FF, (bf16*)(ws + WS_WGU_T + l * WGU_BYTES), 3, A.in[9] + l * DM, scr, r, lane); done = true; break; } r -= I_G;
            if (r < I_D) { tr_item(A.in[27] + (size_t)l * FF * DM, FF, DM, (bf16*)(ws + WS_WD_T + l * WD_BYTES), 0, nullptr, scr, r, lane); done = true; break; } r -= I_D;
        }
        if (done) continue;
        if (r < 4 * I_POOL) { const int g = r / I_POOL; tr_item(A.in[23] + (size_t)g * 65536, 256, 256, (bf16*)(ws + WS_POOL_T) + (size_t)g * 65536, 0, nullptr, scr, r % I_POOL, lane); continue; } r -= 4 * I_POOL;
        if (r < I_W2) { tr_item(A.in[15], 64, 64, (bf16*)(ws + WS_W2T), 0, nullptr, scr, r, lane); continue; } r -= I_W2;
        tr_item(A.in[18], 64, 64, (bf16*)(ws + WS_W2T) + 4096, 0, nullptr, scr, r, lane);
    }
    { GAS v4u* z = (GAS v4u*)(ws + WS_WIN_T + (size_t)2328 * DM * 2); const int n16 = (NIN - 2328) * DM * 2 / 16;
      for (int i = gw * 64 + lane; i < n16; i += NGW * 64) z[i] = (v4u){0u, 0u, 0u, 0u}; }
    for (int idx = gw * 64 + lane; idx < 2 * 16 * 4 * 4 * 64; idx += NGW * 64) {
        const int ln = idx & 63, nbq = (idx >> 6) & 3, ds = (idx >> 8) & 3, l = (idx >> 10) & 15, kv = idx >> 14;
        const float* w1 = A.in[kv ? 17 : 14]; const int r = ln & 31, h = ln >> 5, lp = 16 * (nbq >> 1) + l, e = 32 * (nbq & 1) + r;
        float f[8];
#pragma unroll
        for (int j = 0; j < 8; ++j) f[j] = w1[((size_t)lp * 64 + 32 * h + 8 * ds + j) * 64 + e];
        v4u o; o.x = pk2(f[0], f[1]); o.y = pk2(f[2], f[3]); o.z = pk2(f[4], f[5]); o.w = pk2(f[6], f[7]);
        *((GAS v4u*)(ws + WS_W1F) + idx) = o;
    }
    if (vcu == G - 1) {
        LAS float* red = (LAS float*)(lds + 8 * 16384);
        const int o = tid & 127, part = tid >> 7, kv = o >> 6, e = o & 63; const float* pos = A.in[kv ? 16 : 13]; const float* w1 = A.in[kv ? 17 : 14];
        float s = 0.f;
        for (int k = part * 512; k < part * 512 + 512; ++k) s += pos[k] * w1[(size_t)k * 64 + e];
        red[tid] = s; __syncthreads();
        if (tid < 128) ((float*)(ws + WS_POST))[tid] = (red[tid] + red[tid + 128]) + (red[tid + 256] + red[tid + 384]);
        __syncthreads();
    }
    for (int i = gw * 64 + lane; i < NB * 128 + SB * 128; i += NGW * 64) {
        if (i < NB * 128) { const int b = i >> 7, c = i & 127; ((bf16*)(ws + WS_KCMP_P))[((size_t)b * 256 + 255) * 128 + c] = 0; ((bf16*)(ws + WS_VCMP_P))[((size_t)b * 256 + 255) * 128 + c] = 0; }
        else { const int j = i - NB * 128, b = j >> 7, c = j & 127; ((float*)(ws + WS_KCMP_S))[((size_t)b * 1024 + 1023) * 128 + c] = 0.f; ((float*)(ws + WS_VCMP_S))[((size_t)b * 1024 + 1023) * 128 + c] = 0.f; }
    }
    for (int m = gw; m < MP + SB; m += NGW) {
        if (m < MP) rms_row_to_bf16(A.in[0] + (size_t)m * DM, A.in[8], (bf16*)(ws + WS_H0) + (size_t)m * DM, lane);
        else rms_row_to_bf16(A.in[1] + (size_t)(m - MP) * DM, A.in[8], (bf16*)(ws + WS_HS0) + (size_t)(m - MP) * DM, lane);
    }
}

template <int NBK, class RowBase, class Epi>
__device__ __forceinline__ void skinny_gemm(LAS unsigned char* lds, const bf16* A0, int lda, int acol_per_task16  , const bf16* Bt, int K, int ntasks, int first, int stride, const RowBase& rowbase, const Epi& epi, int tid) {
    const int lane = tid & 63, w = tid >> 6, ks = K >> 3;
    LAS float* part = (LAS float*)lds;
    for (int task = first; task < ntasks; task += stride) {
        f32x4 acc[2][NBK];
#pragma unroll
        for (int i = 0; i < 2; ++i)
#pragma unroll
            for (int j = 0; j < NBK; ++j) acc[i][j] = (f32x4){0.f, 0.f, 0.f, 0.f};
        const bf16* A = A0 + (size_t)(task >> 4) * acol_per_task16;
        int rb[NBK];
#pragma unroll
        for (int j = 0; j < NBK; ++j) rb[j] = rowbase(task, j);
        const int kq = 8 * (lane >> 4), rl = lane & 15;
        for (int k = w * ks; k < (w + 1) * ks; k += 32) {
            const bf16x8 a0 = *(const GAS bf16x8*)(A + (size_t)rl * lda + k + kq), a1 = *(const GAS bf16x8*)(A + (size_t)(16 + rl) * lda + k + kq);
#pragma unroll
            for (int j = 0; j < NBK; ++j) { const bf16x8 b = *(const GAS bf16x8*)(Bt + (size_t)(rb[j] + rl) * K + k + kq);
                acc[0][j] = __builtin_amdgcn_mfma_f32_16x16x32_bf16(a0, b, acc[0][j], 0, 0, 0); acc[1][j] = __builtin_amdgcn_mfma_f32_16x16x32_bf16(a1, b, acc[1][j], 0, 0, 0); }
        }
#pragma unroll
        for (int i = 0; i < 2; ++i)
#pragma unroll
            for (int j = 0; j < NBK; ++j) *(LAS f32x4*)(part + (((w * 2 + i) * NBK + j) * 64 + lane) * 4) = acc[i][j];
        __syncthreads();
        { const int i = tid >> 8, ln = (tid >> 2) & 63, reg = tid & 3; float v[NBK];
#pragma unroll
          for (int j = 0; j < NBK; ++j) { float s = 0.f;
#pragma unroll
              for (int ww = 0; ww < 8; ++ww) s += part[(((ww * 2 + i) * NBK + j) * 64 + ln) * 4 + reg];
              v[j] = s; }
          epi(task, 16 * i + (ln >> 4) * 4 + reg, ln & 15, v); }
        __syncthreads();
    }
}
__device__ __forceinline__ void skinny_rowss(float v2, float* rowss_s, int s, int tid) {
    v2 += __shfl_xor(v2, 4); v2 += __shfl_xor(v2, 8); v2 += __shfl_xor(v2, 16); v2 += __shfl_xor(v2, 32);
    if ((tid & 60) == 0) atomic_addf(rowss_s + s, v2);
}

template <bool SAMPLE>
__device__ __forceinline__ void compress_task(const Args& A, LAS unsigned char* wlds  , int task, int lane) {
    asm volatile("" : "+v"(lane));
    constexpr int TPS = SAMPLE ? 17 : 5, NCH = SAMPLE ? NCH_S : NCH_P, NBLK = SAMPLE ? NBLK_S : NBLK_P;
    const int tile = task % TPS, bkg = task / TPS, g = bkg & 1, kv = (bkg >> 1) & 1, b = bkg >> 2;
    const int n0 = tile * 63, r = lane & 31, h = lane >> 5;
    unsigned char* ws = A.ws;
    const float* base[2];
#pragma unroll
    for (int rbk = 0; rbk < 2; ++rbk) { int n = n0 + 32 * rbk + r; n = n < NCH ? n : NCH - 1;
        if (SAMPLE) { const int page = ((const int*)A.in[7])[b * NPAGE + (n >> 3)]; base[rbk] = A.in[2] + (((size_t)page * PAGE + (n & 7) * 16) * 4 + kv * 2 + g) * 64 + 32 * h; }
        else base[rbk] = A.out + O_CMP_P + ((size_t)(b * SEQ + n * 16) * 256 + kv * 128 + g * 64) + 32 * h; }
    const GAS v4u* W1F = (const GAS v4u*)(ws + WS_W1F) + (size_t)kv * 16384 + lane;
    f32x16 acc[2][4];
#pragma unroll
    for (int i = 0; i < 2; ++i)
#pragma unroll
        for (int j = 0; j < 4; ++j)
#pragma unroll
            for (int e = 0; e < 16; ++e) acc[i][j][e] = 0.f;
    for (int l = 0; l < 16; ++l) {
        bf16x8 af[2][4];
#pragma unroll
        for (int rbk = 0; rbk < 2; ++rbk) { const GAS f32x4* p = (const GAS f32x4*)(base[rbk] + (size_t)l * 256);
#pragma unroll
            for (int ds = 0; ds < 4; ++ds) { const f32x4 x0 = p[2 * ds], x1 = p[2 * ds + 1]; af[rbk][ds] = __builtin_bit_cast(bf16x8, pack8(x0, x1)); } }
#pragma unroll
        for (int ds = 0; ds < 4; ++ds)
#pragma unroll
            for (int nbq = 0; nbq < 4; ++nbq) { const bf16x8 bfr = __builtin_bit_cast(bf16x8, W1F[((l * 4 + ds) * 4 + nbq) * 64]);
                acc[0][nbq] = __builtin_amdgcn_mfma_f32_32x32x16_bf16(af[0][ds], bfr, acc[0][nbq], 0, 0, 0);
                acc[1][nbq] = __builtin_amdgcn_mfma_f32_32x32x16_bf16(af[1][ds], bfr, acc[1][nbq], 0, 0, 0); }
    }
    LAS float* P1 = (LAS float*)wlds;
#pragma unroll
    for (int rbk = 0; rbk < 2; ++rbk)
#pragma unroll
        for (int q = 0; q < 2; ++q)
#pragma unroll
            for (int reg = 0; reg < 16; ++reg) P1[(32 * rbk + (reg & 3) + 8 * (reg >> 2) + 4 * h) * 64 + 32 * q + r] = acc[rbk][2 + q][reg];
    LDS_WAIT(); asm volatile("" ::: "memory");
    const float* post = (const float*)(ws + WS_POST) + kv * 64;
    const float pt0 = post[r], pt1 = post[32 + r];
#pragma unroll
    for (int rbk = 0; rbk < 2; ++rbk)
#pragma unroll
        for (int q = 0; q < 2; ++q)
#pragma unroll
            for (int reg = 0; reg < 16; ++reg) { const int row = 32 * rbk + (reg & 3) + 8 * (reg >> 2) + 4 * h; const int rn = row < 63 ? row + 1 : 63;
                const float x = acc[rbk][q][reg] + P1[rn * 64 + 32 * q + r] + (q ? pt1 : pt0);
                const float t = x + 0.044715f * x * x * x;
                acc[rbk][q][reg] = x * frcp(1.0f + fexp2(-2.3022082f * t)); }
    LDS_WAIT(); asm volatile("" ::: "memory");
    LAS bf16* HB = (LAS bf16*)wlds;
#pragma unroll
    for (int rbk = 0; rbk < 2; ++rbk)
#pragma unroll
        for (int q = 0; q < 2; ++q)
#pragma unroll
            for (int reg = 0; reg < 16; ++reg) HB[(32 * rbk + (reg & 3) + 8 * (reg >> 2) + 4 * h) * 72 + 32 * q + r] = (bf16)f2bf(acc[rbk][q][reg]);
    LDS_WAIT(); asm volatile("" ::: "memory");
    f32x16 o2[2][2];
#pragma unroll
    for (int i = 0; i < 2; ++i)
#pragma unroll
        for (int j = 0; j < 2; ++j)
#pragma unroll
            for (int e = 0; e < 16; ++e) o2[i][j][e] = 0.f;
    const bf16* W2T = (const bf16*)(ws + WS_W2T) + kv * 4096;
#pragma unroll
    for (int ksq = 0; ksq < 4; ++ksq) {
        const bf16x8 a0 = *(const LAS bf16x8*)(HB + r * 72 + 16 * ksq + 8 * h), a1 = *(const LAS bf16x8*)(HB + (32 + r) * 72 + 16 * ksq + 8 * h);
#pragma unroll
        for (int q = 0; q < 2; ++q) { const bf16x8 bfr = *(const GAS bf16x8*)(W2T + (32 * q + r) * 64 + 16 * ksq + 8 * h);
            o2[0][q] = __builtin_amdgcn_mfma_f32_32x32x16_bf16(a0, bfr, o2[0][q], 0, 0, 0); o2[1][q] = __builtin_amdgcn_mfma_f32_32x32x16_bf16(a1, bfr, o2[1][q], 0, 0, 0); }
    }
    LDS_WAIT(); asm volatile("" ::: "memory");
#pragma unroll
    for (int rbk = 0; rbk < 2; ++rbk)
#pragma unroll
        for (int q = 0; q < 2; ++q)
#pragma unroll
            for (int reg = 0; reg < 16; ++reg) { const int row = 32 * rbk + (reg & 3) + 8 * (reg >> 2) + 4 * h, n = n0 + row;
                if (row < 63 && n < NBLK) {
                    if (SAMPLE) ((float*)(ws + (kv ? WS_VCMP_S : WS_KCMP_S)))[((size_t)(b * 1024 + n) * 2 + g) * 64 + 32 * q + r] = o2[rbk][q][reg];
                    else ((bf16*)(ws + (kv ? WS_VCMP_P : WS_KCMP_P)))[((size_t)(b * 256 + n) * 2 + g) * 64 + 32 * q + r] = (bf16)f2bf(o2[rbk][q][reg]); } }
}

__device__ __forceinline__ void conv_ln_rows(const Args& A, LAS float* ybuf  , int nrows, bf16* mix_base  , int tid) {
    const int lane = tid & 63, w = tid >> 6;
    const float* lg = A.in[21]; const float* lb = A.in[22];
    f32x4 g0 = *(const GAS f32x4*)(lg + 8 * lane), g1 = *(const GAS f32x4*)(lg + 8 * lane + 4), b0 = *(const GAS f32x4*)(lb + 8 * lane), b1 = *(const GAS f32x4*)(lb + 8 * lane + 4);
    for (int rr = 0; rr < 4; ++rr) { const int row = 4 * w + rr; if (row >= nrows) break;
        f32x4 y0 = *(const LAS f32x4*)(ybuf + row * 512 + 8 * lane), y1 = *(const LAS f32x4*)(ybuf + row * 512 + 8 * lane + 4);
        const float mu = wave_sum((y0[0] + y0[1]) + (y0[2] + y0[3]) + (y1[0] + y1[1]) + (y1[2] + y1[3])) * (1.0f / CCH);
        y0 -= mu; y1 -= mu;
        const float var = wave_sum((y0[0] * y0[0] + y0[1] * y0[1]) + (y0[2] * y0[2] + y0[3] * y0[3]) + (y1[0] * y1[0] + y1[1] * y1[1]) + (y1[2] * y1[2] + y1[3] * y1[3])) * (1.0f / CCH);
        const float rstd = 1.0f / sqrtf(var + EPS);
        f32x4 z0 = y0 * rstd * g0 + b0, z1 = y1 * rstd * g1 + b1;
#pragma unroll
        for (int e = 0; e < 4; ++e) { z0[e] = z0[e] * sigmoidf_(z0[e]); z1[e] = z1[e] * sigmoidf_(z1[e]); }
        *(GAS v4u*)(mix_base + (size_t)row * DM + 8 * lane) = pack8(z0, z1); }
}
__device__ __forceinline__ void conv_unit_prompt(const Args& A, LAS unsigned char* lds, int unit, int tid) {
    asm volatile("" : "+v"(tid));
    const int b = unit >> 7, t0 = (unit & 127) * 32, c = tid;
    const bf16* a = (const bf16*)(A.ws + WS_AGLU) + (size_t)b * SEQ * CCH + c;
    const float* cw = A.in[19] + c; float w[CONVW];
#pragma unroll
    for (int k = 0; k < CONVW; ++k) w[k] = cw[k * CCH];
    const float bias = A.in[20][c];
    float win[32];
#pragma unroll
    for (int i = 0; i < 32; ++i) { const int t = t0 - 32 + i; win[i] = (t >= 0) ? bf2f(a[(size_t)t * CCH]) : 0.f; }
    LAS float* ybuf = (LAS float*)lds;
#pragma unroll
    for (int i = 0; i < 32; ++i) { win[i] = bf2f(a[(size_t)(t0 + i) * CCH]);
        float y = bias;
#pragma unroll
        for (int k = 0; k < CONVW; ++k) y += w[k] * win[(i - 30 + k) & 31];
        ybuf[i * 512 + c] = y; }
    __syncthreads();
    conv_ln_rows(A, ybuf, 32, (bf16*)(A.ws + WS_MIX) + (size_t)(b * SEQ + t0) * DM + 512, tid);
    __syncthreads();
}
__device__ __forceinline__ void conv_unit_sample(const Args& A, LAS unsigned char* lds, int s, int tid) {
    asm volatile("" : "+v"(tid));
    const int c = tid; const float* zs = (const float*)(A.ws + WS_ZS) + (size_t)s * NIN;
    const int R1 = 1280 + (c >> 7) * 256 + (c & 127);
    const float anew = zs[R1] * sigmoidf_(zs[R1 + 128]);
    const float* st = A.in[5] + (size_t)s * 30 * CCH + c; const float* cw = A.in[19] + c;
    float y = A.in[20][c]; float* oc = A.out + O_CONV_S + (size_t)s * 30 * CCH + c;
    for (int k = 0; k < 30; ++k) { const float e = st[k * CCH]; y += cw[k * CCH] * e; if (k >= 1) oc[(k - 1) * CCH] = e; }
    y += cw[30 * CCH] * anew; oc[29 * CCH] = anew;
    LAS float* ybuf = (LAS float*)lds; ybuf[c] = y;
    __syncthreads();
    conv_ln_rows(A, ybuf, 1, (bf16*)(A.ws + WS_MIXS) + (size_t)s * DM + 512, tid);
    __syncthreads();
}

__device__ __forceinline__ void pool_prep_unit(const Args& A, int unit, int tid) {
    asm volatile("" : "+v"(tid));
    const int b = unit >> 6, t0 = (unit & 63) * 64, c = 2 * tid, gi = c >> 8;
    const float* XR = (const float*)(A.ws + WS_XR) + (size_t)b * SEQ * DM + c; const float* rs = (const float*)(A.ws + WS_ROWSS) + 1 * RS_STRIDE + b * SEQ;
    bf16* Z = (bf16*)(A.ws + WS_Z) + (size_t)b * SEQ * DM + c;
    const f32x2 g = *(const GAS f32x2*)(A.in[8] + DM + c);
    const float wl = (float)(2 << gi);
    f32x2 win[16];
#pragma unroll
    for (int i = 0; i < 16; ++i) win[i] = (f32x2){0.f, 0.f};
    for (int blk = -1; blk < 4; ++blk) {
#pragma unroll
        for (int i = 0; i < 16; ++i) { const int t = t0 + blk * 16 + i;
            f32x2 h = (f32x2){0.f, 0.f};
            if (t >= 0) { const float rstd = __builtin_amdgcn_rsqf(rs[t] * (1.0f / DM) + EPS); h = *(const GAS f32x2*)(XR + (size_t)t * DM) * rstd * g; }
            win[i] = h;
            if (blk >= 0) {
                f32x2 s2 = h + win[(i - 1) & 15];
                f32x2 s4 = s2 + win[(i - 2) & 15] + win[(i - 3) & 15];
                f32x2 s8 = s4 + (win[(i - 4) & 15] + win[(i - 5) & 15]) + (win[(i - 6) & 15] + win[(i - 7) & 15]);
                f32x2 s16 = s8 + ((win[(i - 8) & 15] + win[(i - 9) & 15]) + (win[(i - 10) & 15] + win[(i - 11) & 15])) + ((win[(i - 12) & 15] + win[(i - 13) & 15]) + (win[(i - 14) & 15] + win[(i - 15) & 15]));
                const f32x2 sw = gi == 0 ? s2 : gi == 1 ? s4 : gi == 2 ? s8 : s16;
                const float cnt = fminf(wl, (float)(t + 1));
                const f32x2 z = sw * (1.0f / cnt) - h;
                *(GAS unsigned*)(Z + (size_t)t * DM) = pg8::cvt_pk_bf16(z.x, z.y);
                if (t >= SEQ - POOLB) *(GAS f32x2*)(A.out + O_POOL_P + ((size_t)(b * POOLB + t - (SEQ - POOLB)) * DM + c)) = h;
            } }
    }
}
__device__ __forceinline__ void pool_prep_sample(const Args& A, int s, int tid) {
    asm volatile("" : "+v"(tid));
    const int c = 2 * tid, gi = c >> 8; const int wl = 2 << gi;
    const float rstd = __builtin_amdgcn_rsqf(((const float*)(A.ws + WS_ROWSS))[1 * RS_STRIDE + MP + s] * (1.0f / DM) + EPS);
    const f32x2 g = *(const GAS f32x2*)(A.in[8] + DM + c);
    const f32x2 h = *(const GAS f32x2*)((const float*)(A.ws + WS_XRS) + (size_t)s * DM + c) * rstd * g;
    const float* st = A.in[6] + (size_t)s * POOLB * DM + c; float* op = A.out + O_POOL_S + (size_t)s * POOLB * DM + c;
    f32x2 sw = h;
    for (int k = 0; k < POOLB; ++k) { const f32x2 e = *(const GAS f32x2*)(st + (size_t)k * DM);
        if (15 - k < wl) sw += e;
        if (k >= 1) *(GAS f32x2*)(op + (size_t)(k - 1) * DM) = e; }
    *(GAS f32x2*)(op + (size_t)(POOLB - 1) * DM) = h;
    const f32x2 z = sw * (1.0f / (float)wl) - h;
    *(GAS unsigned*)((bf16*)(A.ws + WS_ZPS) + (size_t)s * DM + c) = pg8::cvt_pk_bf16(z.x, z.y);
}
__device__ __forceinline__ void final_row(const float* xrow, float ss, const float* gain, float* orow, int lane) {
    const float rstd = 1.0f / sqrtf(ss * (1.0f / DM) + EPS);
    const GAS f32x4* xr = (const GAS f32x4*)xrow + lane; const GAS f32x4* gr = (const GAS f32x4*)gain + lane; GAS f32x4* o = (GAS f32x4*)orow + lane;
#pragma unroll
    for (int j = 0; j < 4; ++j) o[64 * j] = xr[64 * j] * rstd * gr[64 * j];
}

constexpr int AT_KV = 0, AT_KVB = 16640  , AT_WSF = 2 * AT_KVB, AT_SA = AT_WSF + 2048, AT_SB = AT_SA + 64 * 65 * 4, AT_SS = AT_SB + 64 * 65 * 4,
              AT_SEL = AT_SS + 64 * 64 * 4, AT_OST = AT_SEL + 512, AT_END = AT_OST + 8 * 4096;
static_assert(AT_END <= RING_BYTES, "attention LDS");
__device__ __forceinline__ int crow(int r, int hi) { return (r & 3) + 8 * (r >> 2) + 4 * hi; }
__device__ __forceinline__ float xhalf_max(float m) { auto rr = __builtin_amdgcn_permlane32_swap(__float_as_uint(m), __float_as_uint(m), false, false); return fmaxf(__uint_as_float(rr[0]), __uint_as_float(rr[1])); }
__device__ __forceinline__ float xhalf_sum(float m) { auto rr = __builtin_amdgcn_permlane32_swap(__float_as_uint(m), __float_as_uint(m), false, false); return __uint_as_float(rr[0]) + __uint_as_float(rr[1]); }
typedef short v4i16_t __attribute__((ext_vector_type(4)));
__device__ __forceinline__ s16x4 vtr(const LAS unsigned char* p) { return __builtin_bit_cast(s16x4, __builtin_amdgcn_ds_read_tr16_b64_v4i16((LAS v4i16_t*)p)); }

struct KVTile { v4u k, v; };
__device__ __forceinline__ KVTile kv_gload(const bf16* Kg, const bf16* Vg, int pitch, int row0, int tid) {
    const int key = tid >> 3, c = tid & 7; KVTile t;
    t.k = *(const GAS v4u*)(Kg + (size_t)(row0 + key) * pitch + c * 8); t.v = *(const GAS v4u*)(Vg + (size_t)(row0 + key) * pitch + c * 8); return t;
}
__device__ __forceinline__ void kv_lwrite(LAS unsigned char* buf, const KVTile& t, int tid) {
    const int key = tid >> 3, c = tid & 7;
    *(LAS v4u*)(buf + c * 1040 + key * 16) = t.k;
    *(LAS v4u*)(buf + 8320 + (c >> 2) * 4160 + key * 64 + (c & 3) * 16) = t.v;
}
struct SmState { float m, l; bool seen; };
template <int MODE>
__device__ __forceinline__ void attn_tile(const LAS unsigned char* buf, const bf16x8 (&qf)[4], SmState& S, f32x16 (&o)[2], int lo, int hi_, bool tilefull, float invl,
                                         LAS float* wsf, LAS float* sA, LAS float* sB, int jbase, int qrow, int lane) {
    const int r32 = lane & 31, hi = lane >> 5;
    const bool laneon = hi_ >= lo;
    const float cinit = (MODE == 1) ? -S.m : (laneon ? -S.m : -INFINITY);
    f32x16 p0, p1; int c0t;
#pragma unroll
    for (int e = 0; e < 16; ++e) { p0[e] = cinit; p1[e] = cinit; }
#pragma unroll
    for (int s = 0; s < 4; ++s) {
        const bf16x8 k0 = *(const LAS bf16x8*)(buf + (2 * s + hi) * 1040 + r32 * 16), k1 = *(const LAS bf16x8*)(buf + (2 * s + hi) * 1040 + (32 + r32) * 16);
        p0 = __builtin_amdgcn_mfma_f32_32x32x16_bf16(k0, qf[s], p0, 0, 0, 0); p1 = __builtin_amdgcn_mfma_f32_32x32x16_bf16(k1, qf[s], p1, 0, 0, 0);
    }
    if (!tilefull) {
        const int lo2 = laneon ? lo : 64, R = laneon ? hi_ - lo : 0, kb0 = 4 * hi - lo2; const float ninf = -INFINITY;
#pragma unroll
        for (int e = 0; e < 16; ++e) { const int c0 = (e & 3) + 8 * (e >> 2);
            asm volatile("v_add_u32 %0, %2, %3\n\tv_cmp_gt_u32 vcc, %0, %4\n\tv_cndmask_b32 %1, %1, %5, vcc" : "=&v"(c0t), "+v"(p0[e]) : "v"(kb0), "n"(c0), "v"(R), "v"(ninf) : "vcc");
            asm volatile("v_add_u32 %0, %2, %3\n\tv_cmp_gt_u32 vcc, %0, %4\n\tv_cndmask_b32 %1, %1, %5, vcc" : "=&v"(c0t), "+v"(p1[e]) : "v"(kb0), "n"(c0 + 32), "v"(R), "v"(ninf) : "vcc"); }
    }
    if (MODE != 1) {
        float rm = fmaxf(p0[0], p1[0]);
#pragma unroll
        for (int e = 1; e < 16; ++e) rm = fmaxf(rm, fmaxf(p0[e], p1[e]));
        rm = xhalf_max(rm);
        const bool valid = rm > -INFINITY;
        const bool need = S.seen ? (rm > 8.0f) : (valid && (rm > 8.0f || rm < -8.0f));
        if (__any(need)) {
            float dl = 0.f, f = 1.f;
            if (valid) { if (!S.seen) dl = rm; else if (rm > 0.f) { dl = rm; f = fexp2(-dl); } }
            S.m += dl; S.l *= f;
#pragma unroll
            for (int e = 0; e < 16; ++e) { p0[e] -= dl; p1[e] -= dl; }
            if (MODE == 2) {
                if (hi == 0) wsf[r32] = f;
                LDS_WAIT(); asm volatile("" ::: "memory");
#pragma unroll
                for (int e = 0; e < 16; ++e) { const float fr_ = wsf[crow(e, hi)]; o[0][e] *= fr_; o[1][e] *= fr_; }
                LDS_WAIT(); asm volatile("" ::: "memory");
            }
        }
        S.seen = S.seen || valid;
    }
    float ls = 0.f;
#pragma unroll
    for (int e = 0; e < 16; ++e) { p0[e] = fexp2(p0[e]); p1[e] = fexp2(p1[e]); ls += p0[e] + p1[e]; }
    if (MODE != 1) S.l += ls;
    if (MODE == 0) return;
    if (MODE == 1) {
#pragma unroll
        for (int e = 0; e < 16; ++e) { p0[e] *= invl; p1[e] *= invl; }
#pragma unroll
        for (int kb = 0; kb < 2; ++kb)
#pragma unroll
            for (int i = 0; i < 4; ++i) { const f32x16& p = kb ? p1 : p0;
                float a = 2.0f * (p[4 * i] + p[4 * i + 1] + p[4 * i + 2]) + p[4 * i + 3], bq = p[4 * i + 3];
                a += __shfl_xor(a, 1); a += __shfl_xor(a, 2); bq += __shfl_xor(bq, 1); bq += __shfl_xor(bq, 2);
                const int j = jbase + 8 * kb + 2 * i + hi;
                if ((lane & 3) == 0) { sA[qrow * 65 + j] = a; sB[qrow * 65 + j + 1] = bq; } }
    }
    bf16x8 pa[4];
#pragma unroll
    for (int ks = 0; ks < 4; ++ks) { const f32x16& p = (ks >> 1) ? p1 : p0; const int b8 = 8 * (ks & 1);
        v4u w; w.x = pg8::cvt_pk_bf16(p[b8], p[b8 + 1]); w.y = pg8::cvt_pk_bf16(p[b8 + 2], p[b8 + 3]); w.z = pg8::cvt_pk_bf16(p[b8 + 4], p[b8 + 5]); w.w = pg8::cvt_pk_bf16(p[b8 + 6], p[b8 + 7]);
        pa[ks] = __builtin_bit_cast(bf16x8, w); }
    const LAS unsigned char* vb = buf + 8320 + ((lane >> 4) & 1) * 32 + (lane & 3) * 8 + (4 * hi + ((lane & 15) >> 2)) * 64;
#pragma unroll
    for (int d0 = 0; d0 < 2; ++d0)
#pragma unroll
        for (int ks = 0; ks < 4; ++ks) { const s16x4 vl = vtr(vb + d0 * 4160 + ks * 1024), vh = vtr(vb + d0 * 4160 + ks * 1024 + 512);
            const bf16x8 vf = (bf16x8){vl[0], vl[1], vl[2], vl[3], vh[0], vh[1], vh[2], vh[3]};
            o[d0] = __builtin_amdgcn_mfma_f32_32x32x16_bf16(pa[ks], vf, o[d0], 0, 0, 0); }
}
__device__ __forceinline__ void fold_branch(f32x16 (&out)[2], const f32x16 (&o)[2], float colfac, LAS float* wsf, int lane) {
    const int r32 = lane & 31, hi = lane >> 5;
    LDS_WAIT(); asm volatile("" ::: "memory");
    if (hi == 0) wsf[r32] = colfac;
    LDS_WAIT(); asm volatile("" ::: "memory");
#pragma unroll
    for (int e = 0; e < 16; ++e) { const float f = wsf[crow(e, hi)]; out[0][e] += o[0][e] * f; out[1][e] += o[1][e] * f; }
    LDS_WAIT(); asm volatile("" ::: "memory");
}
__device__ __forceinline__ void attn_unit_prompt(const Args& A, LAS unsigned char* lds, int b, int g, int qt, int tid) {
    asm volatile("" : "+v"(tid));
    const int lane = tid & 63, w = tid >> 6, r32 = lane & 31, hi = lane >> 5, ql = r32 >> 2, hh = r32 & 3;
    const int qloc = 8 * w + ql, tq = 64 * qt + qloc; const size_t mrow = (size_t)b * SEQ + tq;
    unsigned char* ws = A.ws;
    LAS float* wsf = (LAS float*)(lds + AT_WSF) + w * 64; LAS float* sA = (LAS float*)(lds + AT_SA); LAS float* sB = (LAS float*)(lds + AT_SB); LAS float* sS = (LAS float*)(lds + AT_SS);
    LAS unsigned char* selb = lds + AT_SEL;
    bf16x8 qf[4];
    { const bf16* qp = (const bf16*)(ws + WS_Q) + mrow * 512 + (g * 4 + hh) * 64 + 8 * hi;
#pragma unroll
      for (int s = 0; s < 4; ++s) qf[s] = *(const GAS bf16x8*)(qp + 16 * s); }
    const float* gp = (const float*)(ws + WS_GATES) + mrow * 32 + g * 12 + hh * 3;
    const float gc = sigmoidf_(gp[0]), gs = sigmoidf_(gp[1]), gw_ = sigmoidf_(gp[2]);
    f32x16 out[2], o[2];
#pragma unroll
    for (int e = 0; e < 16; ++e) { out[0][e] = 0.f; out[1][e] = 0.f; o[0][e] = 0.f; o[1][e] = 0.f; }
    for (int i = tid; i < 2 * 64 * 65; i += 512) sA[i] = 0.f;
    const bf16* Kc = (const bf16*)(ws + WS_KCMP_P) + (size_t)b * 256 * 128 + g * 64; const bf16* Vc = (const bf16*)(ws + WS_VCMP_P) + (size_t)b * 256 * 128 + g * 64;
    const int nct = (4 * qt + 2) / 64 + 1;
    const int nmax = (tq - 31) >> 4;
    SmState Sc{0.f, 0.f, false};
#pragma unroll 1
    for (int pass = 0; pass < 2; ++pass) {
        float invl = 0.f;
        if (pass == 1) { const float lt = xhalf_sum(Sc.l); invl = lt > 0.f ? 1.0f / lt : 0.f; }
        KVTile nx = kv_gload(Kc, Vc, 128, 0, tid);
        __syncthreads();
        kv_lwrite(lds + AT_KV, nx, tid);
        __syncthreads();
#pragma unroll 1
        for (int ct = 0; ct < nct; ++ct) {
            if (ct + 1 < nct) nx = kv_gload(Kc, Vc, 128, 64 * (ct + 1), tid);
            const LAS unsigned char* buf = lds + AT_KV + (ct & 1) * AT_KVB;
            const int hiK = nmax - 64 * ct; const bool full = __all(hiK >= 63);
            if (pass == 0) attn_tile<0>(buf, qf, Sc, o, 0, hiK, full, 0.f, wsf, sA, sB, 0, qloc, lane);
            else attn_tile<1>(buf, qf, Sc, o, 0, hiK, full, invl, wsf, sA, sB, 16 * ct, qloc, lane);
            if (ct + 1 < nct) kv_lwrite(lds + AT_KV + ((ct + 1) & 1) * AT_KVB, nx, tid);
            __syncthreads();
        }
    }
    fold_branch(out, o, gc, wsf, lane);
    __syncthreads();
    { const int q = tid >> 3, jj = tid & 7; unsigned key[8]; LAS unsigned* sK = (LAS unsigned*)sS;
#pragma unroll
      for (int e = 0; e < 8; ++e) { const int j = 8 * jj + e; const bool valid = j <= qt, forced = valid && (j == 0 || j == qt || j == qt - 1);
          const float scv = forced ? 1e9f : (valid ? sA[q * 65 + j] + sB[q * 65 + j] : -1e9f);
          unsigned uk = __float_as_uint(scv); uk ^= (uk >> 31) ? 0xFFFFFFFFu : 0x80000000u; key[e] = (uk & ~63u) | (unsigned)(63 - j); sK[q * 64 + j] = key[e]; }
      __syncthreads();
      unsigned rank[8];
#pragma unroll
      for (int e = 0; e < 8; ++e) rank[e] = 0u;
#pragma unroll 2
      for (int j4 = 0; j4 < 16; ++j4) { const v4u k4 = *(const LAS v4u*)(sK + q * 64 + 4 * j4);
#pragma unroll
          for (int e = 0; e < 8; ++e) rank[e] += (k4.x > key[e] ? 1u : 0u) + (k4.y > key[e] ? 1u : 0u) + (k4.z > key[e] ? 1u : 0u) + (k4.w > key[e] ? 1u : 0u); }
      unsigned bits = 0u;
#pragma unroll
      for (int e = 0; e < 8; ++e) bits |= (rank[e] < 16u ? 1u : 0u) << e;
      selb[q * 8 + jj] = (unsigned char)bits; }
    __syncthreads();
    const unsigned sel_lo = *(const LAS unsigned*)(selb + qloc * 8), sel_hi = *(const LAS unsigned*)(selb + qloc * 8 + 4);
    {
        const bf16* Kg = (const bf16*)(ws + WS_KS) + (size_t)b * SEQ * 256 + g * 64; const bf16* Vg = Kg + 128;
#pragma unroll
        for (int e = 0; e < 16; ++e) { o[0][e] = 0.f; o[1][e] = 0.f; }
        SmState S{0.f, 0.f, false};
        KVTile nx = kv_gload(Kg, Vg, 256, 0, tid);
        __syncthreads();
        kv_lwrite(lds + AT_KV, nx, tid);
        __syncthreads();
#pragma unroll 1
        for (int j = 0; j <= qt; ++j) {
            if (j < qt) nx = kv_gload(Kg, Vg, 256, 64 * (j + 1), tid);
            const LAS unsigned char* buf = lds + AT_KV + (j & 1) * AT_KVB;
            const bool selj = ((j < 32 ? sel_lo >> j : sel_hi >> (j - 32)) & 1u) != 0u;
            const int hiK = selj ? (j == qt ? qloc : 63) : -1;
            attn_tile<2>(buf, qf, S, o, 0, hiK, j != qt, 0.f, wsf, sA, sB, 0, qloc, lane);
            if (j < qt) kv_lwrite(lds + AT_KV + ((j + 1) & 1) * AT_KVB, nx, tid);
            __syncthreads();
        }
        const float lt = xhalf_sum(S.l);
        fold_branch(out, o, lt > 0.f ? gs / lt : 0.f, wsf, lane);
    }
    {
        const bf16* Kg = (const bf16*)(ws + WS_KW) + (size_t)b * SEQ * 256 + g * 64; const bf16* Vg = Kg + 128;
#pragma unroll
        for (int e = 0; e < 16; ++e) { o[0][e] = 0.f; o[1][e] = 0.f; }
        SmState S{0.f, 0.f, false};
        const int j0 = qt >= 8 ? qt - 8 : 0;
        KVTile nx = kv_gload(Kg, Vg, 256, 64 * j0, tid);
        __syncthreads();
        kv_lwrite(lds + AT_KV, nx, tid);
        __syncthreads();
#pragma unroll 1
        for (int j = j0; j <= qt; ++j) {
            if (j < qt) nx = kv_gload(Kg, Vg, 256, 64 * (j + 1), tid);
            const LAS unsigned char* buf = lds + AT_KV + ((j - j0) & 1) * AT_KVB;
            const int loK = (j == qt - 8) ? qloc + 1 : 0, hiK = (j == qt) ? qloc : 63;
            attn_tile<2>(buf, qf, S, o, loK, hiK, !(j == qt || j == qt - 8), 0.f, wsf, sA, sB, 0, qloc, lane);
            if (j < qt) kv_lwrite(lds + AT_KV + ((j + 1 - j0) & 1) * AT_KVB, nx, tid);
            __syncthreads();
        }
        const float lt = xhalf_sum(S.l);
        fold_branch(out, o, lt > 0.f ? gw_ / lt : 0.f, wsf, lane);
    }
    { LAS bf16* stg = (LAS bf16*)(lds + AT_OST) + w * 2048;
#pragma unroll
      for (int e = 0; e < 16; ++e) { const int orow = crow(e, hi);
#pragma unroll
          for (int d0 = 0; d0 < 2; ++d0) stg[orow * 64 + d0 * 32 + r32] = (bf16)f2bf(out[d0][e]); }
      LDS_WAIT(); asm volatile("" ::: "memory");
      bf16* mix = (bf16*)(ws + WS_MIX);
#pragma unroll
      for (int i = 0; i < 4; ++i) { const int row = i * 8 + (lane >> 3), ch = lane & 7; const v4u v = *(const LAS v4u*)(stg + row * 64 + ch * 8);
          const int q2 = row >> 2, h2 = row & 3;
          *(GAS v4u*)(mix + ((size_t)b * SEQ + 64 * qt + 8 * w + q2) * DM + (g * 4 + h2) * 64 + ch * 8) = v; }
      LDS_WAIT(); asm volatile("" ::: "memory"); }
    __syncthreads();
}

constexpr int SA_Q = 0, SA_SC = 1024, SA_RED = SA_SC + 4 * 1024 * 4, SA_SS = SA_RED + 512, SA_LIST = SA_SS + 264 * 4, SA_OACC = SA_LIST + 64, SA_OUT = SA_OACC + 2 * 256 * 4, SA_END = SA_OUT + 256 * 4;
__device__ __forceinline__ void block_max4(float (&v)[4], LAS float* red, int tid) {
#pragma unroll
    for (int h = 0; h < 4; ++h) v[h] = wave_max(v[h]);
    __syncthreads();
    if ((tid & 63) == 0) {
#pragma unroll
        for (int h = 0; h < 4; ++h) red[(tid >> 6) * 4 + h] = v[h]; }
    __syncthreads();
#pragma unroll
    for (int h = 0; h < 4; ++h) { float m = red[h];
#pragma unroll
        for (int w = 1; w < 8; ++w) m = fmaxf(m, red[w * 4 + h]);
        v[h] = m; }
}
__device__ __forceinline__ void block_sum4(float (&v)[4], LAS float* red, int tid) {
#pragma unroll
    for (int h = 0; h < 4; ++h) v[h] = wave_sum(v[h]);
    __syncthreads();
    if ((tid & 63) == 0) {
#pragma unroll
        for (int h = 0; h < 4; ++h) red[(tid >> 6) * 4 + h] = v[h]; }
    __syncthreads();
#pragma unroll
    for (int h = 0; h < 4; ++h) { float m = red[h];
#pragma unroll
        for (int w = 1; w < 8; ++w) m += red[w * 4 + h];
        v[h] = m; }
}
template <class KRow, class VRow>
__device__ __forceinline__ void sample_branch(LAS unsigned char* lds, int nkeys, const KRow& krow, const VRow& vrow, const float (&gate)[4], int tid) {
    LAS float* qs = (LAS float*)(lds + SA_Q); LAS float* sc = (LAS float*)(lds + SA_SC); LAS float* red = (LAS float*)(lds + SA_RED);
    LAS float* oacc = (LAS float*)(lds + SA_OACC); LAS float* OUT = (LAS float*)(lds + SA_OUT);
    float mx[4] = {-INFINITY, -INFINITY, -INFINITY, -INFINITY};
    for (int i = tid; i < 1024; i += 512) {
        float s[4] = {-INFINITY, -INFINITY, -INFINITY, -INFINITY};
        const float* kr = (i < nkeys) ? krow(i) : nullptr;
        if (kr) { s[0] = s[1] = s[2] = s[3] = 0.f;
#pragma unroll
            for (int d4 = 0; d4 < 16; ++d4) { const f32x4 kv = *(const GAS f32x4*)(kr + 4 * d4);
#pragma unroll
                for (int h = 0; h < 4; ++h) { const f32x4 q = *(const LAS f32x4*)(qs + h * 64 + 4 * d4); s[h] += (kv[0] * q[0] + kv[1] * q[1]) + (kv[2] * q[2] + kv[3] * q[3]); } } }
#pragma unroll
        for (int h = 0; h < 4; ++h) { sc[h * 1024 + i] = s[h]; mx[h] = fmaxf(mx[h], s[h]); }
    }
    block_max4(mx, red, tid);
    float sm[4] = {0.f, 0.f, 0.f, 0.f};
    for (int i = tid; i < 1024; i += 512) {
#pragma unroll
        for (int h = 0; h < 4; ++h) { const float s = sc[h * 1024 + i]; const float e = (s > -INFINITY && mx[h] > -INFINITY) ? fexp2(s - mx[h]) : 0.f; sc[h * 1024 + i] = e; sm[h] += e; }
    }
    block_sum4(sm, red, tid);
    for (int i = tid; i < 1024; i += 512) {
#pragma unroll
        for (int h = 0; h < 4; ++h) sc[h * 1024 + i] *= (sm[h] > 0.f ? 1.0f / sm[h] : 0.f);
    }
    __syncthreads();
    { const int half = tid >> 8, h = (tid >> 6) & 3, d = tid & 63; float acc = 0.f;
      const int i0 = half * 512, i1 = (nkeys < i0 + 512) ? nkeys : i0 + 512;
      for (int i = i0; i < i1; ++i) { const float* vr = vrow(i); if (vr) acc += sc[h * 1024 + i] * vr[d]; }
      oacc[half * 256 + h * 64 + d] = acc; }
    __syncthreads();
    if (tid < 256) { const int hq = tid >> 6; const float gt = hq == 0 ? gate[0] : hq == 1 ? gate[1] : hq == 2 ? gate[2] : gate[3]; OUT[tid] += gt * (oacc[tid] + oacc[256 + tid]); }
    __syncthreads();
}
__device__ __forceinline__ void attn_unit_sample(const Args& A, LAS unsigned char* lds, int b, int g, int tid) {
    asm volatile("" : "+v"(tid));
    unsigned char* ws = A.ws;
    const float* zs = (const float*)(ws + WS_ZS) + (size_t)b * NIN;
    LAS float* qs = (LAS float*)(lds + SA_Q); LAS float* sc = (LAS float*)(lds + SA_SC); LAS float* ss = (LAS float*)(lds + SA_SS); LAS int* list = (LAS int*)(lds + SA_LIST); LAS float* OUT = (LAS float*)(lds + SA_OUT);
    __syncthreads();
    if (tid < 256) { qs[tid] = zs[g * 256 + tid] * QSCALE; OUT[tid] = 0.f; }
    float gate[3][4];
#pragma unroll
    for (int h = 0; h < 4; ++h)
#pragma unroll
        for (int br = 0; br < 3; ++br) gate[br][h] = sigmoidf_(zs[2304 + g * 12 + h * 3 + br]);
    __syncthreads();
    const int* pt = (const int*)A.in[7] + b * NPAGE;
    { const float* Kc = (const float*)(ws + WS_KCMP_S) + ((size_t)b * 1024 * 2 + g) * 64; const float* Vc = (const float*)(ws + WS_VCMP_S) + ((size_t)b * 1024 * 2 + g) * 64;
      sample_branch(lds, NBLK_S, [&](int i) { return Kc + (size_t)i * 128; }, [&](int i) { return Vc + (size_t)i * 128; }, gate[0], tid); }
    if (tid < 264) { float s = -2e9f;
        if (tid < 257) { const int j = tid; float imp[5];
#pragma unroll
            for (int e = 0; e < 5; ++e) { const int n = 4 * j - 1 + e; float v = 0.f; if (n >= 0 && n < NBLK_S) v = (sc[n] + sc[1024 + n]) + (sc[2048 + n] + sc[3072 + n]); imp[e] = v; }
            s = imp[0] + 2.0f * (imp[1] + imp[2] + imp[3]) + imp[4];
            if (j == 0 || j == 255 || j == 256) s = 1e9f; }
        ss[tid] = s; }
    __syncthreads();
    if (tid < 257) { const float s = ss[tid]; int rank = 0;
        for (int j2 = 0; j2 < 257; ++j2) { const float s2 = ss[j2]; rank += (s2 > s || (s2 == s && j2 < tid)) ? 1 : 0; }
        if (rank < 16) list[rank] = tid; }
    __syncthreads();
    { const float* cache = A.in[3]; const float* knew = zs + 768 + g * 64; const float* vnew = zs + 768 + 128 + g * 64;
      auto rowp = [&](int i, int kv) -> const float* { const int blk = list[i >> 6], pos = blk * 64 + (i & 63);
          if (pos > PAST) return (const float*)nullptr; if (pos == PAST) return kv ? vnew : knew;
          const int page = pt[pos >> 7]; return cache + ((((size_t)page * PAGE + (pos & 127)) * 2 + kv) * 2 + g) * 64; };
      sample_branch(lds, 1024, [&](int i) { return rowp(i, 0); }, [&](int i) { return rowp(i, 1); }, gate[1], tid); }
    { const float* wb = A.in[4] + (size_t)b * 512 * 256; const float* knew = zs + 1024 + g * 64; const float* vnew = zs + 1024 + 128 + g * 64;
      auto rowp = [&](int i, int kv) -> const float* { if (i == 511) return kv ? vnew : knew; return wb + ((size_t)(i + 1) * 4 + kv * 2 + g) * 64; };
      sample_branch(lds, 512, [&](int i) { return rowp(i, 0); }, [&](int i) { return rowp(i, 1); }, gate[2], tid); }
    if (tid < 256) ((bf16*)(ws + WS_MIXS))[(size_t)b * DM + g * 256 + tid] = (bf16)f2bf(OUT[tid]);
    __syncthreads();
}

constexpr int N_PHASES = 12;
__global__ void __launch_bounds__(NWAVES * 64, 2) nsa_hybrid_fwd(Args args) {
    extern __shared__ __attribute__((aligned(16))) unsigned char lds_raw[];
    LAS unsigned char* lds = (LAS unsigned char*)lds_raw;
    volatile LAS unsigned* MISC = (volatile LAS unsigned*)(lds + MISC_OFF);
    const int G = gridDim.x, bx = blockIdx.x, vcu = (G % 8 == 0) ? (bx % 8) * (G / 8) + bx / 8 : bx;
    gu32* ctl = (gu32*)(args.ws + WS_CTL);
    for (int u = threadIdx.x; u < (LDS_BYTES - LDSCTL_OFF) / 4; u += NWAVES * 64) ((LAS unsigned*)(lds + LDSCTL_OFF))[u] = 0u;
    __syncthreads();
    XcdBarrier bar; bar.bar = (unsigned*)(ctl + CW_BAR); bar.x = 0; bar.st = nullptr;
    if (!MK_PER_PHASE) bar = xcd_barrier_post((unsigned*)(ctl + CW_BAR), MISC + 8);
    const int lo = args.ph_lo, hi = args.ph_hi;
#ifndef PH_MASK
#define PH_MASK 0xFFF
#endif
#define IN(k) (((PH_MASK >> (k)) & 1) && lo <= (k) && (k) < hi)
#define SEAM(k) do { if (IN(k) && IN((k) + 1)) xcd_barrier(bar); } while (0)
#define PHASE_ARGS() const __attribute__((address_space(4))) Args* kp_ = (const __attribute__((address_space(4))) Args*)__builtin_amdgcn_kernarg_segment_ptr(); asm volatile("" : "+s"(kp_)); \
    const Args A = *(const Args*)kp_; unsigned char* const ws = A.ws; float* const rowss = (float*)(ws + WS_ROWSS); \
    bf16* const H0 = (bf16*)(ws + WS_H0); bf16* const XB = (bf16*)(ws + WS_XB); float* const XR = (float*)(ws + WS_XR); bf16* const HF = (bf16*)(ws + WS_HF); \
    float* const XRS = (float*)(ws + WS_XRS); bf16* const XBS = (bf16*)(ws + WS_XBS); bf16* const HFS = (bf16*)(ws + WS_HFS); \
    (void)rowss; (void)H0; (void)XB; (void)XR; (void)HF; (void)XRS; (void)XBS; (void)HFS; \
    int tid = threadIdx.x; asm volatile("" : "+v"(tid)); const int lane = tid & 63, wave = __builtin_amdgcn_readfirstlane(tid >> 6); (void)lane; (void)wave;

    if (IN(0)) { PHASE_ARGS(); p0_prologue(A, lds, vcu, G, tid); }
    SEAM(0);
    if (IN(1)) { PHASE_ARGS();
        pg8::Gemm g{H0, (const bf16*)(ws + WS_WIN_T), MP, NIN, DM, DM, 0}; pg8::StaticOrder S; S.init(MP, NIN, G, bx);
        EpiInProj E{(bf16*)(ws + WS_Q), (bf16*)(ws + WS_KS), (bf16*)(ws + WS_KW), (bf16*)(ws + WS_AGLU), (float*)(ws + WS_GATES), A.out};
        pg8::gemm_phase<EpiInProj, pg8::StaticOrder, true, true>(lds, g, S, E);
        float* ZS = (float*)(ws + WS_ZS);
        skinny_gemm<1>(lds, (const bf16*)(ws + WS_HS0), DM, 0, (const bf16*)(ws + WS_WIN_T), DM, NIN / 16, bx, G, [](int task, int) { return 16 * task; },
            [&](int task, int s, int c, const float (&v)[1]) { ZS[(size_t)s * NIN + 16 * task + c] = v[0]; }, tid);
    }
    SEAM(1);
    if (IN(2)) { PHASE_ARGS();
        const int gw = vcu * NWAVES + wave, NGW = G * NWAVES;
        for (int t = gw; t < 2176 + 160; t += NGW) { if (t < 2176) compress_task<true>(A, lds + wave * 16384, t, lane); else compress_task<false>(A, lds + wave * 16384, t - 2176, lane); }
        __syncthreads();
        for (int u = vcu; u < 1024 + SB; u += G) { if (u < 1024) conv_unit_prompt(A, lds, u, tid); else conv_unit_sample(A, lds, u - 1024, tid); }
        const float* ZS = (const float*)(ws + WS_ZS);
        for (size_t i = (size_t)vcu * 512 + tid; i < (size_t)SB * 512 * 64; i += (size_t)G * 512) { const int s = (int)(i >> 15), r = (int)((i >> 6) & 511), c4 = (int)(i & 63);
            f32x4 v; if (r < 511) v = *(const GAS f32x4*)(A.in[4] + ((size_t)(s * 512 + r + 1) * 256 + 4 * c4)); else v = *(const GAS f32x4*)(ZS + (size_t)s * NIN + 1024 + 4 * c4);
            *(GAS f32x4*)(A.out + O_WIN_S + ((size_t)(s * 512 + r) * 256 + 4 * c4)) = v; }
        for (int i = vcu * 512 + tid; i < SB * 256; i += G * 512) { const int s = i >> 8, c = i & 255; A.out[O_CMP_S + i] = ZS[(size_t)s * NIN + 512 + c]; A.out[O_SLC_S + i] = ZS[(size_t)s * NIN + 768 + c]; }
    }
    SEAM(2);
    if (IN(3)) { PHASE_ARGS();
#ifndef NO_SAMPLE_ATTN
        if (vcu < 2 * SB) attn_unit_sample(A, lds, vcu >> 1, vcu & 1, tid);
#endif
#ifndef NO_PROMPT_ATTN
#pragma unroll 1
        for (int p2 = 2 * vcu; p2 < 1024; p2 += 2 * G) {
#pragma unroll 1
            for (int uu = 0; uu < 2; ++uu) { const int p = p2 >> 1, bg = p >> 5, qa = p & 31; attn_unit_prompt(A, lds, bg >> 1, bg & 1, uu ? qa : 63 - qa, tid); } }
#endif
    }
    SEAM(3);
    if (IN(4)) { PHASE_ARGS();
        pg8::Gemm g{(const bf16*)(ws + WS_MIX), (const bf16*)(ws + WS_WOUT_T), MP, DM, DM, DM, 0}; pg8::StaticOrder S; S.init(MP, DM, G, bx);
        EpiRes<true, false, true> E{A.in[0], XR, XB, nullptr, rowss + 0 * RS_STRIDE};
        pg8::gemm_phase<EpiRes<true, false, true>, pg8::StaticOrder, true, true>(lds, g, S, E);
        const float* xs = A.in[1]; float* rs = rowss + 0 * RS_STRIDE + MP;
        skinny_gemm<1>(lds, (const bf16*)(ws + WS_MIXS), DM, 0, (const bf16*)(ws + WS_WOUT_T), DM, DM / 16, bx, G, [](int task, int) { return 16 * task; },
            [&](int task, int s, int c, const float (&v)[1]) { const size_t o = (size_t)s * DM + 16 * task + c; const float x1 = xs[o] + v[0]; XRS[o] = x1; XBS[o] = (bf16)f2bf(x1); skinny_rowss(x1 * x1, rs, s, tid); }, tid);
    }
    SEAM(4);
#define FFN_PHASES(L, PGU, PDN, RS_IN, RS_OUT) \
    if (IN(PGU)) { PHASE_ARGS(); \
        pg8::Gemm g{XB, (const bf16*)(ws + WS_WGU_T + (L) * WGU_BYTES), MP, NGU, DM, DM, 0}; pg8::StaticOrder S; S.init(MP, NGU, G, bx); \
        EpiGateUp E{HF, rowss + (RS_IN) * RS_STRIDE}; \
        pg8::gemm_phase<EpiGateUp, pg8::StaticOrder, true, true>(lds, g, S, E); \
        const float* rs = rowss + (RS_IN) * RS_STRIDE + MP; \
        skinny_gemm<2>(lds, XBS, DM, 0, (const bf16*)(ws + WS_WGU_T + (L) * WGU_BYTES), DM, FF / 16, bx, G, [](int task, int j) { return 256 * ((16 * task) >> 7) + ((16 * task) & 127) + 128 * j; }, \
            [&](int task, int s, int c, const float (&v)[2]) { const float rstd = 1.0f / sqrtf(rs[s] * (1.0f / DM) + EPS); const float gg = v[0] * rstd, uu = v[1] * rstd; \
                HFS[(size_t)s * FF + 16 * task + c] = (bf16)f2bf(gg * sigmoidf_(gg) * uu); }, tid); \
    } \
    SEAM(PGU); \
    if (IN(PDN)) { PHASE_ARGS(); \
        pg8::Gemm g{HF, (const bf16*)(ws + WS_WD_T + (L) * WD_BYTES), MP, DM, FF, FF, 0}; pg8::StaticOrder S; S.init(MP, DM, G, bx); \
        EpiRes<false, false, false> E{nullptr, XR, nullptr, nullptr, rowss + (RS_OUT) * RS_STRIDE}; \
        pg8::gemm_phase<EpiRes<false, false, false>, pg8::StaticOrder, true, true>(lds, g, S, E); \
        float* rs = rowss + (RS_OUT) * RS_STRIDE + MP; \
        skinny_gemm<1>(lds, HFS, FF, 0, (const bf16*)(ws + WS_WD_T + (L) * WD_BYTES), FF, DM / 16, bx, G, [](int task, int) { return 16 * task; }, \
            [&](int task, int s, int c, const float (&v)[1]) { const size_t o = (size_t)s * DM + 16 * task + c; const float x2 = XRS[o] + v[0]; XRS[o] = x2; skinny_rowss(x2 * x2, rs, s, tid); }, tid); \
    } \
    SEAM(PDN);
    FFN_PHASES(0, 5, 6, 0, 1)
    if (IN(7)) { PHASE_ARGS();
        for (int u = vcu; u < 512 + SB; u += G) { if (u < 512) pool_prep_unit(A, u, tid); else pool_prep_sample(A, u - 512, tid); }
    }
    SEAM(7);
    if (IN(8)) { PHASE_ARGS();
        pg8::Gemm g{(const bf16*)(ws + WS_Z), (const bf16*)(ws + WS_POOL_T), MP, DM, 256, DM, 256}; pg8::StaticOrder S; S.init(MP, DM, G, bx);
        EpiRes<false, true, true> E{nullptr, XR, XB, A.in[24], rowss + 2 * RS_STRIDE};
        pg8::gemm_phase<EpiRes<false, true, true>, pg8::StaticOrder, true, true>(lds, g, S, E);
        float* rs = rowss + 2 * RS_STRIDE + MP; const float* psc = A.in[24];
        skinny_gemm<1>(lds, (const bf16*)(ws + WS_ZPS), DM, 256, (const bf16*)(ws + WS_POOL_T), 256, DM / 16, bx, G, [](int task, int) { return 16 * task; },
            [&](int task, int s, int c, const float (&v)[1]) { const int col = 16 * task + c; const size_t o = (size_t)s * DM + col; const float x3 = XRS[o] + v[0] * psc[col]; XRS[o] = x3; XBS[o] = (bf16)f2bf(x3); skinny_rowss(x3 * x3, rs, s, tid); }, tid);
    }
    SEAM(8);
    FFN_PHASES(1, 9, 10, 2, 3)
    if (IN(11)) { PHASE_ARGS();
        const int gw = vcu * NWAVES + wave, NGW = G * NWAVES; const float* rs = rowss + 3 * RS_STRIDE;
        for (int m = gw; m < MP + SB; m += NGW) {
            if (m < MP) final_row(XR + (size_t)m * DM, rs[m], A.in[10], A.out + O_Y + (size_t)m * DM, lane);
            else final_row(XRS + (size_t)(m - MP) * DM, rs[m], A.in[10], A.out + O_YS + (size_t)(m - MP) * DM, lane); }
    }
#undef IN
#undef SEAM
}

extern "C" void kernel_launch(void* const* d_in, const int* in_sizes, int n_in, void* d_out, int out_size, void* d_ws, size_t ws_size, hipStream_t stream) {
    static int grid = 0;
    if (grid == 0) {
        if (n_in != 28 || (size_t)out_size != O_END || ws_size < WS_END) { fprintf(stderr, "kernel_launch: unexpected shapes: n_in %d out %d ws %zu\n", n_in, out_size, ws_size); grid = -1; return; }
        int dev = 0, cus = 0, per_cu = 0;
        if (hipGetDevice(&dev) != hipSuccess || hipDeviceGetAttribute(&cus, hipDeviceAttributeMultiprocessorCount, dev) != hipSuccess) { grid = -1; return; }
        if (hipFuncSetAttribute((const void*)nsa_hybrid_fwd, hipFuncAttributeMaxDynamicSharedMemorySize, LDS_BYTES) != hipSuccess) { fprintf(stderr, "kernel_launch: hipFuncSetAttribute failed\n"); grid = -1; return; }
        if (hipOccupancyMaxActiveBlocksPerMultiprocessor(&per_cu, (const void*)nsa_hybrid_fwd, NWAVES * 64, LDS_BYTES) != hipSuccess || per_cu < 1)
            fprintf(stderr, "kernel_launch: note: occupancy query reports %d workgroups per CU\n", per_cu);
        (void)hipGetLastError();
        grid = cus;
    }
    if (grid < 0) return;
    if (hipMemsetAsync((char*)d_ws + WS_CTL, 0, CTL_ZERO_BYTES, stream) != hipSuccess) { fprintf(stderr, "kernel_launch: memset failed\n"); return; }
    Args a{};
    for (int i = 0; i < 28; ++i) a.in[i] = (const float*)d_in[i];
    a.out = (float*)d_out; a.ws = (unsigned char*)d_ws;
#if MK_PER_PHASE
    for (int ph = 0; ph < N_PHASES; ++ph) { a.ph_lo = ph; a.ph_hi = ph + 1; hipLaunchKernelGGL(nsa_hybrid_fwd, dim3(grid), dim3(NWAVES * 64), LDS_BYTES, stream, a); }
#else
    a.ph_lo = 0; a.ph_hi = N_PHASES;
    hipLaunchKernelGGL(nsa_hybrid_fwd, dim3(grid), dim3(NWAVES * 64), LDS_BYTES, stream, a);
#endif
    const hipError_t le = hipPeekAtLastError();
    if (le != hipSuccess) fprintf(stderr, "kernel_launch: launch failed: %s\n", hipGetErrorName(le));
}
```

```cpp
#include <hip/hip_runtime.h>
#include <cstdio>
#include <cstdint>
#ifndef PROBE_REPEAT
#define PROBE_REPEAT -1
#define PROBE_NREP 1
#endif
#ifndef REP_COMPRESS
#define REP_COMPRESS 1
#define REP_CONV 1
#define REP_SAMPLE 1
#define REP_PROMPT 1
#endif
#ifndef PROBE_PHASE
#define PROBE_PHASE -1
#endif
#ifndef MK_PER_PHASE
#define MK_PER_PHASE 0
#endif
namespace pg8 {
#define PG8_LAS __attribute__((address_space(3)))
typedef unsigned short bf16_t;
typedef short bf16x8 __attribute__((ext_vector_type(8)));
typedef float f32x4 __attribute__((ext_vector_type(4)));
typedef unsigned u32x4 __attribute__((ext_vector_type(4)));
constexpr int BM = 256, BK = 64, HALF = 128, HTB = HALF * BK * 2  , STAGE_BYTES = 8 * HTB, NXCD = 8, WGM = 4;

__host__ __device__ __forceinline__ int lds_byte(int r, int c) { const int st = (r >> 4) * 2 + (c >> 5), rr = r & 15, cc = c & 31, ob = rr * 64 + cc * 2; return st * 1024 + (ob ^ (((ob >> 9) & 1) << 5)); }
__host__ __device__ __forceinline__ void stage_rc(int b, int& R, int& C) { const int st = b / 1024, sb = b % 1024, swz = sb ^ (((sb >> 9) & 1) << 5); R = (st >> 1) * 16 + swz / 64; C = (st & 1) * 32 + (swz % 64) / 2; }
__host__ __device__ __forceinline__ int perm32(int rho) { const int n = rho >> 4, i = rho & 15; return 8 * (i >> 2) + 4 * n + (i & 3); }

struct Unit { int pm, pn; };
struct Gemm { const bf16_t* A; const bf16_t* Bt; int M, N, K, lda, acol; };

struct StaticOrder {
    int nM, nN, nwg, G, c;
    __host__ __device__ void init(int M, int N, int G_, int c_) { nM = M / BM; nN = N / BM; nwg = nM * nN; G = G_; c = c_; }
    __host__ __device__ bool next(int i, Unit& u) const {
        const long L = (long)i * G + c; if (L >= nwg) return false;
        int wgid = (int)L; { const int q = nwg / NXCD, r = nwg % NXCD, xcd = wgid % NXCD, off = wgid / NXCD; wgid = (xcd < r ? xcd * (q + 1) : r * (q + 1) + (xcd - r) * q) + off; }
        const int nig = WGM * nN, gid = wgid / nig, fm = gid * WGM, gsz = (nM - fm) < WGM ? (nM - fm) : WGM;
        u.pm = fm + ((wgid % nig) % gsz); u.pn = (wgid % nig) / gsz; return true;
    }
    __device__ __forceinline__ void a_ready(const Unit&) const {}
    __device__ __forceinline__ void done(const Unit&) const {}
};
__device__ __forceinline__ unsigned cvt_pk_bf16(float lo, float hi) { unsigned r; asm volatile("v_cvt_pk_bf16_f32 %0, %1, %2" : "=v"(r) : "v"(lo), "v"(hi)); return r; }
template <class Epi, class Sched, bool ALIGN_EPI = false, bool SP2 = false>
__device__ __forceinline__ void gemm_phase(PG8_LAS unsigned char* lds, const Gemm g, const Sched& S, const Epi& E) {
    const int tid = threadIdx.x, wid = __builtin_amdgcn_readfirstlane(tid >> 6), lane = tid & 63, wr = wid >> 2, wc = wid & 3, fr = lane & 15, fq = lane >> 4;
    const int K = g.K, nt = K / BK, lda = g.lda;
    unsigned voffA[2], voffB[2];
#pragma unroll
    for (int i = 0; i < 2; ++i) { int R, C; stage_rc(tid * 16 + i * 8192, R, C); const int Rb = Epi::PERM ? ((R & ~31) + perm32(R & 31)) : R;
        voffA[i] = (unsigned)(R * lda + C) * 2u; voffB[i] = (unsigned)(Rb * K + C) * 2u; }
    const size_t kstep = (size_t)(BK * 2);
    const size_t hstepA = (size_t)HALF * lda * 2, hstepB = (size_t)HALF * K * 2;
    const size_t tstepA = 2 * hstepA, tstepB = 2 * hstepB; const size_t acolb = (size_t)g.acol * 2;
    const unsigned ldsw = (unsigned)wid * 1024u;
    const int aoff = lds_byte(wr * 64 + fr, fq * 8), boff = lds_byte(wc * 32 + fr, fq * 8);
#define PG8_SA(b, h) (((b) * 2 + (h)) * HTB)
#define PG8_SB(b, h) ((4 + (b) * 2 + (h)) * HTB)
#define PG8_STAGE(bufoff, gbase, voff) do { _Pragma("unroll") for (int _i = 0; _i < 2; ++_i) \
        __builtin_amdgcn_global_load_lds((const unsigned*)((const char*)(gbase) + (voff)[_i]), (PG8_LAS unsigned*)(lds + (bufoff) + ldsw + _i * 8192), 16, 0, 0); } while (0)
#define PG8_LDA(dst, b, h) do { _Pragma("unroll") for (int m = 0; m < 4; ++m) _Pragma("unroll") for (int k = 0; k < 2; ++k) dst[m][k] = *(const PG8_LAS bf16x8*)(lds + PG8_SA(b, h) + aoff + m * 2048 + k * 1024); } while (0)
#define PG8_LDB(dst, b, h) do { _Pragma("unroll") for (int n = 0; n < 2; ++n) _Pragma("unroll") for (int k = 0; k < 2; ++k) dst[n][k] = *(const PG8_LAS bf16x8*)(lds + PG8_SB(b, h) + boff + n * 2048 + k * 1024); } while (0)
#define PG8_MMA(ai, bj, At, Bt) do { __builtin_amdgcn_s_setprio(1); _Pragma("unroll") for (int m = 0; m < 4; ++m) _Pragma("unroll") for (int n = 0; n < 2; ++n) _Pragma("unroll") for (int k = 0; k < 2; ++k) \
        acc[ai][bj][m][n] = __builtin_amdgcn_mfma_f32_16x16x32_bf16(Bt[n][k], At[m][k], acc[ai][bj][m][n], 0, 0, 0); __builtin_amdgcn_s_setprio(0); } while (0)
#define PG8_WAIT_V(n) asm volatile("s_waitcnt vmcnt(" #n ")" ::: "memory")
#define PG8_WAIT_L(n) asm volatile("s_waitcnt lgkmcnt(" #n ")" ::: "memory")
#define PG8_BAR __builtin_amdgcn_s_barrier()
#define PG8_SCHED __builtin_amdgcn_sched_barrier(0)
    Unit cur, nxt; int ui = 0;
    if (!S.next(0, cur)) return;
    f32x4 acc[2][2][4][2];
#pragma unroll
    for (int a = 0; a < 2; ++a)
#pragma unroll
        for (int b = 0; b < 2; ++b)
#pragma unroll
            for (int m = 0; m < 4; ++m)
#pragma unroll
                for (int n = 0; n < 2; ++n) acc[a][b][m][n] = (f32x4){0.f, 0.f, 0.f, 0.f};
    bf16x8 At[4][2], B0[2][2], B1[2][2];
    const char* cA = (const char*)g.A + (size_t)cur.pm * tstepA + (size_t)cur.pn * acolb; const char* cB = (const char*)g.Bt + (size_t)cur.pn * tstepB;
    S.a_ready(cur);
    if constexpr (SP2) {
        PG8_STAGE(PG8_SB(0, 0), cB, voffB); PG8_STAGE(PG8_SB(0, 1), cB + hstepB, voffB); PG8_STAGE(PG8_SA(0, 0), cA, voffA); PG8_STAGE(PG8_SA(0, 1), cA + hstepA, voffA);
        if (wr == 1) PG8_BAR;
        PG8_WAIT_V(2); PG8_BAR;
        PG8_STAGE(PG8_SB(1, 0), cB + kstep, voffB); PG8_STAGE(PG8_SA(1, 0), cA + kstep, voffA); PG8_STAGE(PG8_SB(1, 1), cB + hstepB + kstep, voffB);
        PG8_WAIT_V(6); PG8_BAR;
    } else {
        PG8_STAGE(PG8_SB(0, 0), cB, voffB); PG8_STAGE(PG8_SA(0, 0), cA, voffA); PG8_STAGE(PG8_SB(0, 1), cB + hstepB, voffB); PG8_STAGE(PG8_SA(0, 1), cA + hstepA, voffA);
        if (wr == 1) PG8_BAR;
        PG8_WAIT_V(4); PG8_BAR;
        PG8_STAGE(PG8_SB(1, 0), cB + kstep, voffB); PG8_STAGE(PG8_SA(1, 0), cA + kstep, voffA); PG8_STAGE(PG8_SB(1, 1), cB + hstepB + kstep, voffB);
        PG8_WAIT_V(6); PG8_BAR;
    }
    for (;;) {
        const bool has_next = S.next(ui + 1, nxt);
        const char* nA = has_next ? (const char*)g.A + (size_t)nxt.pm * tstepA + (size_t)nxt.pn * acolb : cA; const char* nB = has_next ? (const char*)g.Bt + (size_t)nxt.pn * tstepB : cB;
#pragma unroll 1
        for (int t = 0; t < nt; t += 2) {
            const bool last = (t == nt - 2);
            const char* a1 = cA + (size_t)(t + 1) * kstep;
            const char* a2 = last ? nA : cA + (size_t)(t + 2) * kstep; const char* b2 = last ? nB : cB + (size_t)(t + 2) * kstep;
            const char* a3 = a2 + kstep; const char* b3 = b2 + kstep;
            if (last && has_next) S.a_ready(nxt);
            if constexpr (SP2) {
            PG8_LDB(B0, 0, 0); PG8_LDB(B1, 0, 1); PG8_SCHED; PG8_LDA(At, 0, 0); PG8_STAGE(PG8_SA(1, 1), a1 + hstepA, voffA);
            PG8_WAIT_V(8); PG8_WAIT_L(0); PG8_BAR; PG8_MMA(0, 0, At, B0); PG8_MMA(0, 1, At, B1); PG8_BAR; PG8_SCHED;
            PG8_LDA(At, 0, 1); PG8_STAGE(PG8_SB(0, 0), b2, voffB); PG8_STAGE(PG8_SB(0, 1), b2 + hstepB, voffB); PG8_STAGE(PG8_SA(0, 0), a2, voffA);
            PG8_WAIT_V(8); PG8_WAIT_L(0); PG8_BAR; PG8_MMA(1, 0, At, B0); PG8_MMA(1, 1, At, B1); PG8_BAR; PG8_SCHED;
            PG8_LDB(B0, 1, 0); PG8_LDB(B1, 1, 1); PG8_SCHED; PG8_LDA(At, 1, 0); PG8_STAGE(PG8_SA(0, 1), a2 + hstepA, voffA);
            PG8_WAIT_V(8); PG8_WAIT_L(0); PG8_BAR; PG8_MMA(0, 0, At, B0); PG8_MMA(0, 1, At, B1); PG8_BAR; PG8_SCHED;
            PG8_LDA(At, 1, 1); PG8_STAGE(PG8_SB(1, 0), b3, voffB); PG8_STAGE(PG8_SB(1, 1), b3 + hstepB, voffB); PG8_STAGE(PG8_SA(1, 0), a3, voffA);
            PG8_WAIT_V(8); PG8_WAIT_L(0); PG8_BAR; PG8_MMA(1, 0, At, B0); PG8_MMA(1, 1, At, B1); PG8_BAR; PG8_SCHED;
            } else {
            PG8_LDB(B0, 0, 0); PG8_SCHED; PG8_LDA(At, 0, 0); PG8_STAGE(PG8_SA(1, 1), a1 + hstepA, voffA);
            PG8_WAIT_L(8); PG8_BAR; PG8_WAIT_L(0); PG8_MMA(0, 0, At, B0); PG8_BAR; PG8_SCHED;
            PG8_LDB(B1, 0, 1); PG8_STAGE(PG8_SB(0, 0), b2, voffB);
            PG8_BAR; PG8_WAIT_L(0); PG8_MMA(0, 1, At, B1); PG8_BAR;
            PG8_LDA(At, 0, 1); PG8_STAGE(PG8_SA(0, 0), a2, voffA);
            PG8_BAR; PG8_WAIT_L(0); PG8_MMA(1, 0, At, B0); PG8_BAR; PG8_SCHED;
            PG8_STAGE(PG8_SB(0, 1), b2 + hstepB, voffB);
            PG8_WAIT_V(6); PG8_BAR; PG8_MMA(1, 1, At, B1); PG8_BAR;
            PG8_LDB(B0, 1, 0); PG8_SCHED; PG8_LDA(At, 1, 0); PG8_STAGE(PG8_SA(0, 1), a2 + hstepA, voffA);
            PG8_WAIT_L(8); PG8_BAR; PG8_WAIT_L(0); PG8_MMA(0, 0, At, B0); PG8_BAR; PG8_SCHED;
            PG8_LDB(B1, 1, 1); PG8_STAGE(PG8_SB(1, 0), b3, voffB);
            PG8_BAR; PG8_WAIT_L(0); PG8_MMA(0, 1, At, B1); PG8_BAR;
            PG8_LDA(At, 1, 1); PG8_STAGE(PG8_SA(1, 0), a3, voffA);
            PG8_BAR; PG8_WAIT_L(0); PG8_MMA(1, 0, At, B0); PG8_BAR; PG8_SCHED;
            PG8_STAGE(PG8_SB(1, 1), b3 + hstepB, voffB);
            PG8_WAIT_V(6); PG8_BAR; PG8_MMA(1, 1, At, B1); PG8_BAR;
            }
        }
        if constexpr (ALIGN_EPI) { if (wr == 0) PG8_BAR; }
        if constexpr (!Epi::AFTER_DRAIN) { E(acc, cur, wr, wc, fr, fq); S.done(cur); }
        if (!has_next) break;
#pragma unroll
        for (int a = 0; a < 2; ++a)
#pragma unroll
            for (int b = 0; b < 2; ++b)
#pragma unroll
                for (int m = 0; m < 4; ++m)
#pragma unroll
                    for (int n = 0; n < 2; ++n) acc[a][b][m][n] = (f32x4){0.f, 0.f, 0.f, 0.f};
        cur = nxt; cA = nA; cB = nB; ++ui;
        if constexpr (ALIGN_EPI) { if (wr == 1) PG8_BAR; }
    }
    PG8_WAIT_V(0);
    if constexpr (!ALIGN_EPI) { if (wr == 0) PG8_BAR; }
    PG8_BAR;
    if constexpr (Epi::AFTER_DRAIN) { E.fused(acc, cur, wr, wc, fr, fq, lds, wid, lane); S.done(cur); }
#undef PG8_SA
#undef PG8_SB
#undef PG8_STAGE
#undef PG8_LDA
#undef PG8_LDB
#undef PG8_MMA
#undef PG8_WAIT_V
#undef PG8_WAIT_L
#undef PG8_BAR
#undef PG8_SCHED
}
}

constexpr int NWAVES = 8;
constexpr int DM = 1024, SEQ = 4096, NB = 8, MP = NB * SEQ;
constexpr int SB = 32, PAST = 16384, NPAGE = 128, PAGE = 128;
constexpr int IN_A = 2328, NIN = 2560, FF = 2816, NGU = 2 * FF;
constexpr int CONVW = 31, CCH = 512, POOLB = 15;
constexpr float EPS = 1e-6f;
constexpr float LOG2E = 1.4426950408889634f;
constexpr float QSCALE = 0.125f * LOG2E;
constexpr int NCH_S = 1024, NBLK_S = 1023, NCH_P = 256, NBLK_P = 255;
constexpr size_t O_Y = 0, O_YS = 33554432, O_CMP_P = 33587200, O_CMP_S = 41975808, O_SLC_P = 41984000, O_SLC_S = 50372608,
                 O_WIN_P = 50380800, O_WIN_S = 51429376, O_CONV_P = 55623680, O_CONV_S = 55746560, O_POOL_P = 56238080, O_POOL_S = 56360960, O_END = 56852480;
constexpr size_t MiB = 1u << 20;
constexpr size_t WS_CTL = 0, CTL_ZERO_BYTES = 2 * MiB;
constexpr size_t WS_ROWSS = 1 * MiB;
constexpr int RS_STRIDE = MP + SB;
constexpr size_t WS_POSTQ = 1 * MiB + 768 * 1024;
constexpr size_t WS_WIN_T = 4 * MiB, WS_WOUT_T = 10 * MiB, WS_WGU_T = 12 * MiB, WS_WD_T = 34 * MiB, WS_POOL_T = 46 * MiB, WS_W1F = 47 * MiB, WS_W2T = 48 * MiB;
constexpr size_t WGU_BYTES = (size_t)NGU * DM * 2, WD_BYTES = (size_t)DM * FF * 2;
constexpr size_t WS_HS0 = 49 * MiB, WS_ZS = WS_HS0 + 65536, WS_MIXS = WS_ZS + 327680, WS_XRS = WS_MIXS + 65536, WS_XBS = WS_XRS + 131072, WS_HFS = WS_XBS + 65536, WS_ZPS = WS_HFS + 180224;
constexpr size_t WS_KCMP_P = 52 * MiB, WS_VCMP_P = 53 * MiB, WS_KCMP_S = 54 * MiB, WS_VCMP_S = 70 * MiB;
constexpr size_t WS_H0 = 96 * MiB, WS_Q = 160 * MiB, WS_KS = 192 * MiB, WS_KW = 208 * MiB, WS_GATES = 224 * MiB, WS_AGLU = 232 * MiB, WS_MIX = 264 * MiB,
                 WS_XR = 328 * MiB, WS_XB = 456 * MiB, WS_HF = 520 * MiB, WS_Z = 696 * MiB, WS_END = 768 * MiB;
static_assert(WS_ZPS + 65536 <= WS_KCMP_P && WS_WGU_T + 2 * WGU_BYTES <= WS_WD_T && WS_WD_T + 2 * WD_BYTES <= WS_POOL_T, "ws map");
constexpr int CW_TMO = 0, CW_BAR = 4096, CW_Q3 = 8192, CW_SPC = 16384  ;
constexpr int RING_BYTES = 147456, LDSCTL_OFF = RING_BYTES, MISC_OFF = LDSCTL_OFF + 320, LDS_BYTES = 148480;

#define GAS __attribute__((address_space(1)))
#define LAS __attribute__((address_space(3)))
typedef unsigned short bf16;
typedef unsigned v4u __attribute__((ext_vector_type(4)));
typedef float f32x4 __attribute__((ext_vector_type(4)));
typedef short bf16x8 __attribute__((ext_vector_type(8)));
typedef GAS unsigned gu32;
typedef GAS unsigned long long gu64;
#define RLX_AGENT __ATOMIC_RELAXED, __HIP_MEMORY_SCOPE_AGENT
#define LDS_WAIT() asm volatile("s_waitcnt lgkmcnt(0)" ::: "memory")
#define VM_WAIT() asm volatile("s_waitcnt vmcnt(0)" ::: "memory")
__device__ __forceinline__ unsigned long long rt() { return __builtin_amdgcn_s_memrealtime(); }
__device__ __forceinline__ unsigned f2bf(float f) { unsigned u = __builtin_bit_cast(unsigned, f); return (u + 0x7fffu + ((u >> 16) & 1u)) >> 16; }
__device__ __forceinline__ unsigned pk2(float lo, float hi) { return f2bf(lo) | (f2bf(hi) << 16); }

#define XB_TMO      128
#define XB_XCNT(j)  (256  + 64 * (j))
#define XB_XSUB(j)  (1280 + 64 * (j))
#define XB_XGEN(j)  (2304 + 64 * (j))
#define XB_TOP      3328
#define XB_TOPGEN   3392
#define XCD_BAR_WORDS 3456
#define XB_SPIN_CAP (1u << 18)

__device__ __forceinline__ unsigned xb_ld(unsigned* p)              { return __hip_atomic_load(p, __ATOMIC_RELAXED, __HIP_MEMORY_SCOPE_AGENT); }
__device__ __forceinline__ unsigned xb_add(unsigned* p, unsigned v) { return __hip_atomic_fetch_add(p, v, __ATOMIC_RELAXED, __HIP_MEMORY_SCOPE_AGENT); }
__device__ __forceinline__ unsigned xb_xcc_id() { return (unsigned)__builtin_amdgcn_s_getreg((3 << 11) | 20) & 0xFu; }
#define XB_SPIN(cond, bar) do { unsigned _sp = 0; while (cond) { __builtin_amdgcn_s_sleep(1); \
    if ((++_sp & 255u) == 0u) { if (xb_ld(&(bar)[XB_TMO])) break; if (_sp > XB_SPIN_CAP) { atomicAdd(&(bar)[XB_TMO], 1u); break; } } } } while (0)

struct XcdBarrier {
    unsigned* bar; unsigned x;
    volatile LAS unsigned* st;
};

__device__ __forceinline__ XcdBarrier xcd_barrier_post(unsigned* bar, volatile LAS unsigned* st) {
    XcdBarrier b; b.bar = bar; b.x = xb_xcc_id(); b.st = st;
    if (threadIdx.x == 0) (void)xb_add(&bar[XB_XCNT(b.x)], 1u);
    return b;
}
__device__ __forceinline__ void xcd_barrier_complete(unsigned* bar, unsigned x, unsigned& nloc, unsigned& nx) {
    const unsigned G = gridDim.x * gridDim.y * gridDim.z;
    unsigned sum, cnt, mine, sp = 0u;
    for (;;) {
        sum = 0u; cnt = 0u; mine = 0u;
#pragma unroll
        for (unsigned j = 0; j < 16; ++j) { const unsigned c = xb_ld(&bar[XB_XCNT(j)]); sum += c; cnt += (c > 0u) ? 1u : 0u; mine = (j == x) ? c : mine; }
        if (sum == G) break;
        __builtin_amdgcn_s_sleep(1);
        if ((++sp & 255u) == 0u) { if (xb_ld(&bar[XB_TMO])) break; if (sp > XB_SPIN_CAP) { atomicAdd(&bar[XB_TMO], 1u); break; } }
    }
    nloc = mine > 0u ? mine : 1u; nx = cnt > 0u ? cnt : 1u;
}

__device__ __forceinline__ void xcd_barrier(const XcdBarrier& b) {
    asm volatile("s_waitcnt vmcnt(0)" ::: "memory");
    __syncthreads();
    if (threadIdx.x == 0) {
        unsigned* bar = b.bar;
        __builtin_amdgcn_s_waitcnt(0);
        unsigned nloc = b.st[0], nx = b.st[1];
        if (nloc == 0u) { xcd_barrier_complete(bar, b.x, nloc, nx); b.st[0] = nloc; b.st[1] = nx; }
        const unsigned old = xb_add(&bar[XB_XSUB(b.x)], 1u);
        const unsigned gen = old / nloc;
        if (old + 1u == (gen + 1u) * nloc) {
            __builtin_amdgcn_fence(__ATOMIC_RELEASE, "agent");
            asm volatile("s_waitcnt vmcnt(0)" ::: "memory");
            const unsigned og = xb_add(&bar[XB_TOP], 1u);
            const unsigned tg = og / nx;
            if (og + 1u == (tg + 1u) * nx) xb_add(&bar[XB_TOPGEN], 1u);
            else XB_SPIN(xb_ld(&bar[XB_TOPGEN]) == tg, bar);
            __builtin_amdgcn_fence(__ATOMIC_ACQUIRE, "agent");
            xb_add(&bar[XB_XGEN(b.x)], 1u);
            asm volatile("s_waitcnt vmcnt(0)" ::: "memory");
        } else {
            XB_SPIN(xb_ld(&bar[XB_XGEN(b.x)]) == gen, bar);
            __builtin_amdgcn_fence(__ATOMIC_ACQUIRE, "agent");
            asm volatile("s_waitcnt vmcnt(0)" ::: "memory");
        }
    }
    __syncthreads();
}

typedef float f32x16 __attribute__((ext_vector_type(16)));
typedef float f32x2 __attribute__((ext_vector_type(2)));
typedef short s16x4 __attribute__((ext_vector_type(4)));
typedef unsigned u32x2 __attribute__((ext_vector_type(2)));
__device__ __forceinline__ float bf2f(unsigned short u) { return __builtin_bit_cast(float, (unsigned)u << 16); }
__device__ __forceinline__ float bflo(unsigned w) { return __builtin_bit_cast(float, w << 16); }
__device__ __forceinline__ float bfhi(unsigned w) { return __builtin_bit_cast(float, w & 0xffff0000u); }
__device__ __forceinline__ float fexp2(float x) { return __builtin_amdgcn_exp2f(x); }
__device__ __forceinline__ float frcp(float x) { return __builtin_amdgcn_rcpf(x); }
__device__ __forceinline__ float sigmoidf_(float x) { return frcp(1.0f + fexp2(-x * LOG2E)); }
__device__ __forceinline__ float wave_sum(float v) {
#pragma unroll
    for (int o = 1; o < 64; o <<= 1) v += __shfl_xor(v, o);
    return v;
}
__device__ __forceinline__ float wave_max(float v) {
#pragma unroll
    for (int o = 1; o < 64; o <<= 1) v = fmaxf(v, __shfl_xor(v, o));
    return v;
}
__device__ __forceinline__ void atomic_addf(float* p, float v) { __hip_atomic_fetch_add(p, v, __ATOMIC_RELAXED, __HIP_MEMORY_SCOPE_AGENT); }
__device__ __forceinline__ v4u pack8(const f32x4 a, const f32x4 b) { v4u w; w.x = pg8::cvt_pk_bf16(a[0], a[1]); w.y = pg8::cvt_pk_bf16(a[2], a[3]); w.z = pg8::cvt_pk_bf16(b[0], b[1]); w.w = pg8::cvt_pk_bf16(b[2], b[3]); return w; }

struct Args { const float* in[28]; float* out; unsigned char* ws; int ph_lo, ph_hi; };
struct Frame {
    LAS unsigned char* lds; volatile LAS unsigned* MISC; gu32* ctl;
    int tid, lane, wave, vcu, G;
    const float* const* in; float* out; unsigned char* ws;
};

using pg8::Unit;
struct EpiInProj {
    static constexpr bool PERM = true, AFTER_DRAIN = false;
    bf16* Q; bf16* KS; bf16* KW; bf16* AGLU; float* GATES; float* out;
    __device__ __forceinline__ void operator()(const f32x4 (&acc)[2][2][4][2], const Unit& u, int wr, int wc, int fr, int fq) const {
        const int row0 = u.pm * 256 + wr * 64 + fr, cw = wc * 32 + 8 * fq, pn = u.pn;
        if (pn < 2) {
#pragma unroll
            for (int ai = 0; ai < 2; ++ai)
#pragma unroll
                for (int m = 0; m < 4; ++m) { const int row = row0 + ai * 128 + m * 16;
#pragma unroll
                    for (int bj = 0; bj < 2; ++bj) *(GAS v4u*)(Q + (size_t)row * 512 + pn * 256 + bj * 128 + cw) = pack8(acc[ai][bj][m][0] * QSCALE, acc[ai][bj][m][1] * QSCALE); }
        } else if (pn == 2 || pn == 3) {
            float* o = out + (pn == 2 ? O_CMP_P : O_SLC_P);
#pragma unroll
            for (int ai = 0; ai < 2; ++ai)
#pragma unroll
                for (int m = 0; m < 4; ++m) { const int row = row0 + ai * 128 + m * 16;
#pragma unroll
                    for (int bj = 0; bj < 2; ++bj) { const size_t off = (size_t)row * 256 + bj * 128 + cw;
                        *(GAS f32x4*)(o + off) = acc[ai][bj][m][0]; *(GAS f32x4*)(o + off + 4) = acc[ai][bj][m][1];
                        if (pn == 3) *(GAS v4u*)(KS + off) = pack8(acc[ai][bj][m][0], acc[ai][bj][m][1]); } }
        } else if (pn == 4) {
#pragma unroll
            for (int ai = 0; ai < 2; ++ai)
#pragma unroll
                for (int m = 0; m < 4; ++m) { const int row = row0 + ai * 128 + m * 16; const int t = row & (SEQ - 1), b = row >> 12;
#pragma unroll
                    for (int bj = 0; bj < 2; ++bj) { const size_t off = (size_t)row * 256 + bj * 128 + cw;
                        *(GAS v4u*)(KW + off) = pack8(acc[ai][bj][m][0], acc[ai][bj][m][1]);
                        if (t >= SEQ - 512) { float* o = out + O_WIN_P + ((size_t)(b * 512 + t - (SEQ - 512)) * 256 + bj * 128 + cw);
                            *(GAS f32x4*)(o) = acc[ai][bj][m][0]; *(GAS f32x4*)(o + 4) = acc[ai][bj][m][1]; } } }
        } else if (pn < 9) {
            const int j = pn - 5;
#pragma unroll
            for (int ai = 0; ai < 2; ++ai)
#pragma unroll
                for (int m = 0; m < 4; ++m) { const int row = row0 + ai * 128 + m * 16; const int t = row & (SEQ - 1), b = row >> 12;
                    f32x4 a0, a1;
#pragma unroll
                    for (int e = 0; e < 4; ++e) { a0[e] = acc[ai][0][m][0][e] * sigmoidf_(acc[ai][1][m][0][e]); a1[e] = acc[ai][0][m][1][e] * sigmoidf_(acc[ai][1][m][1][e]); }
                    const int col = j * 128 + cw;
                    *(GAS v4u*)(AGLU + (size_t)row * 512 + col) = pack8(a0, a1);
                    if (t >= SEQ - (CONVW - 1)) { float* o = out + O_CONV_P + ((size_t)(b * (CONVW - 1) + t - (SEQ - (CONVW - 1))) * CCH + col);
                        *(GAS f32x4*)(o) = a0; *(GAS f32x4*)(o + 4) = a1; } }
        } else {
            if (wc == 0) {
#pragma unroll
                for (int ai = 0; ai < 2; ++ai)
#pragma unroll
                    for (int m = 0; m < 4; ++m) { const int row = row0 + ai * 128 + m * 16; float* o = GATES + (size_t)row * 32 + 8 * fq;
                        *(GAS f32x4*)(o) = acc[ai][0][m][0]; *(GAS f32x4*)(o + 4) = acc[ai][0][m][1]; }
            }
        }
    }
};
template <bool FROM_X, bool SCALE> struct EpiRes {
    static constexpr bool PERM = true, AFTER_DRAIN = false;
    const float* xin; bf16* XB; const float* scale; float* rowss;
    __device__ __forceinline__ void operator()(const f32x4 (&acc)[2][2][4][2], const Unit& u, int wr, int wc, int fr, int fq) const {
        const int row0 = u.pm * 256 + wr * 64 + fr, col0 = u.pn * 256 + wc * 32 + 8 * fq;
        f32x4 s0[2], s1[2];
        if (SCALE) {
#pragma unroll
            for (int bj = 0; bj < 2; ++bj) { s0[bj] = *(const GAS f32x4*)(scale + col0 + bj * 128); s1[bj] = *(const GAS f32x4*)(scale + col0 + bj * 128 + 4); } }
#pragma unroll
        for (int ai = 0; ai < 2; ++ai) {
            f32x4 ra[4][2], rb[4][2]; v4u rw[4][2];
#pragma unroll
            for (int m = 0; m < 4; ++m)
#pragma unroll
                for (int bj = 0; bj < 2; ++bj) { const size_t off = (size_t)(row0 + ai * 128 + m * 16) * DM + col0 + bj * 128;
                    if (FROM_X) { ra[m][bj] = *(const GAS f32x4*)(xin + off); rb[m][bj] = *(const GAS f32x4*)(xin + off + 4); } else rw[m][bj] = *(const GAS v4u*)(XB + off); }
#pragma unroll
            for (int m = 0; m < 4; ++m) { const int row = row0 + ai * 128 + m * 16; float ss = 0.f;
#pragma unroll
                for (int bj = 0; bj < 2; ++bj) { const size_t off = (size_t)row * DM + col0 + bj * 128;
                    f32x4 v0, v1;
                    if (FROM_X) { v0 = ra[m][bj]; v1 = rb[m][bj]; }
                    else { const v4u w = rw[m][bj]; v0 = (f32x4){bflo(w.x), bfhi(w.x), bflo(w.y), bfhi(w.y)}; v1 = (f32x4){bflo(w.z), bfhi(w.z), bflo(w.w), bfhi(w.w)}; }
                    if (SCALE) { v0 += acc[ai][bj][m][0] * s0[bj]; v1 += acc[ai][bj][m][1] * s1[bj]; } else { v0 += acc[ai][bj][m][0]; v1 += acc[ai][bj][m][1]; }
                    *(GAS v4u*)(XB + off) = pack8(v0, v1);
                    ss += (v0[0] * v0[0] + v0[1] * v0[1]) + (v0[2] * v0[2] + v0[3] * v0[3]) + (v1[0] * v1[0] + v1[1] * v1[1]) + (v1[2] * v1[2] + v1[3] * v1[3]); }
                ss += __shfl_xor(ss, 16); ss += __shfl_xor(ss, 32);
                if (fq == 0) atomic_addf(rowss + row, ss); }
        }
    }
};
struct EpiGateUp {
    static constexpr bool PERM = true, AFTER_DRAIN = false;
    bf16* HF; const float* rowss;
    __device__ __forceinline__ void operator()(const f32x4 (&acc)[2][2][4][2], const Unit& u, int wr, int wc, int fr, int fq) const {
        const int row0 = u.pm * 256 + wr * 64 + fr, col = u.pn * 128 + wc * 32 + 8 * fq;
#pragma unroll
        for (int ai = 0; ai < 2; ++ai)
#pragma unroll
            for (int m = 0; m < 4; ++m) { const int row = row0 + ai * 128 + m * 16;
                const float rstd = __builtin_amdgcn_rsqf(*(const GAS float*)(rowss + row) * (1.0f / DM) + EPS);
                f32x4 h0, h1;
#pragma unroll
                for (int e = 0; e < 4; ++e) { const float g0 = acc[ai][0][m][0][e] * rstd, u0 = acc[ai][1][m][0][e] * rstd, g1 = acc[ai][0][m][1][e] * rstd, u1 = acc[ai][1][m][1][e] * rstd;
                    h0[e] = g0 * sigmoidf_(g0) * u0; h1[e] = g1 * sigmoidf_(g1) * u1; }
                *(GAS v4u*)(HF + (size_t)row * FF + col) = pack8(h0, h1); }
    }
};

__device__ __forceinline__ int map_in(int n) {
    if (n < 1280) return n;
    if (n < 1304) return 2304 + (n - 1280);
    const int uu = n - 1304, half = uu >> 9, c = uu & 511;
    return 1280 + (c >> 7) * 256 + half * 128 + (c & 127);
}
__device__ __forceinline__ void tr_item(const float* W, int K, int N, bf16* WT, int mode, const float* gain, int item, int lane) {
    asm volatile("" : "+v"(lane));
    const int nblk = (N + 63) / 64, kb = item / nblk, nb = item % nblk, k0 = 64 * kb, n = 64 * nb + lane;
    const bool ok = n < N; const int nn = ok ? n : N - 1;
    const float* src = W + (size_t)k0 * N + nn;
    float v[64];
#pragma unroll
    for (int i = 0; i < 64; ++i) v[i] = *(const GAS float*)(src + (size_t)i * N);
    if (gain) {
#pragma unroll
        for (int i = 0; i < 64; ++i) v[i] *= gain[k0 + i]; }
    int r = n; if (mode == 1) r = map_in(nn); else if (mode == 2) r = 256 * (nn >> 7) + (nn & 127); else if (mode == 3) r = 256 * (nn >> 7) + 128 + (nn & 127);
    if (ok) { GAS v4u* dst = (GAS v4u*)(WT + (size_t)r * K + k0);
#pragma unroll
        for (int c = 0; c < 8; ++c) { v4u o; o.x = pk2(v[8 * c], v[8 * c + 1]); o.y = pk2(v[8 * c + 2], v[8 * c + 3]); o.z = pk2(v[8 * c + 4], v[8 * c + 5]); o.w = pk2(v[8 * c + 6], v[8 * c + 7]); dst[c] = o; } }
}
template <int NR>
__device__ __forceinline__ void rms_rows_to_bf16(const float* const (&xrow)[NR], const float* gain, bf16* const (&orow)[NR], int lane) {
    const GAS f32x4* gr = (const GAS f32x4*)gain + lane;
    f32x4 v[NR][4];
#pragma unroll
    for (int q = 0; q < NR; ++q) { const GAS f32x4* xr = (const GAS f32x4*)xrow[q] + lane;
#pragma unroll
        for (int j = 0; j < 4; ++j) v[q][j] = xr[64 * j]; }
    f32x4 g[4];
#pragma unroll
    for (int j = 0; j < 4; ++j) g[j] = gr[64 * j];
#pragma unroll
    for (int q = 0; q < NR; ++q) { float s = 0.f;
#pragma unroll
        for (int j = 0; j < 4; ++j) s += (v[q][j].x * v[q][j].x + v[q][j].y * v[q][j].y) + (v[q][j].z * v[q][j].z + v[q][j].w * v[q][j].w);
        const float rstd = 1.0f / sqrtf(wave_sum(s) * (1.0f / DM) + EPS);
        GAS unsigned long long* o8 = (GAS unsigned long long*)orow[q] + lane;
#pragma unroll
        for (int j = 0; j < 4; ++j)
            o8[64 * j] = (unsigned long long)pk2(v[q][j].x * rstd * g[j].x, v[q][j].y * rstd * g[j].y) | ((unsigned long long)pk2(v[q][j].z * rstd * g[j].z, v[q][j].w * rstd * g[j].w) << 32); }
}
__device__ __forceinline__ void ffn_weight_item(const Args& A, int idx, int lane) {
    unsigned char* ws = A.ws; const int l = idx / 2112, r = idx % 2112, which = r / 704, item = r % 704;
    if (which == 0) tr_item(A.in[25] + (size_t)l * DM * FF, DM, FF, (bf16*)(ws + WS_WGU_T + l * WGU_BYTES), 2, A.in[9] + l * DM, item, lane);
    else if (which == 1) tr_item(A.in[26] + (size_t)l * DM * FF, DM, FF, (bf16*)(ws + WS_WGU_T + l * WGU_BYTES), 3, A.in[9] + l * DM, item, lane);
    else tr_item(A.in[27] + (size_t)l * FF * DM, FF, DM, (bf16*)(ws + WS_WD_T + l * WD_BYTES), 0, nullptr, item, lane);
}
__device__ __forceinline__ void p0_prologue(const Args& A, LAS unsigned char* lds, int vcu, int G, int tid) {
    const int lane = tid & 63, wave = tid >> 6;
    unsigned char* ws = A.ws;
    const int gw = vcu * NWAVES + wave, NGW = G * NWAVES;
    constexpr int I_IN = 16 * 37, I_OUT = 16 * 16, I_POOL = 4 * 4, I_W2 = 1;
    constexpr int NITEMS = I_IN + I_OUT + 4 * I_POOL + 2 * I_W2;
#pragma unroll 1
    for (int it = wave * G + vcu; it < NITEMS; it += NGW) {
        int r = it;
        if (r < I_IN) { tr_item(A.in[11], DM, IN_A, (bf16*)(ws + WS_WIN_T), 1, nullptr, r, lane); continue; } r -= I_IN;
        if (r < I_OUT) { tr_item(A.in[12], DM, DM, (bf16*)(ws + WS_WOUT_T), 0, nullptr, r, lane); continue; } r -= I_OUT;
        if (r < 4 * I_POOL) { const int g = r / I_POOL; tr_item(A.in[23] + (size_t)g * 65536, 256, 256, (bf16*)(ws + WS_POOL_T) + (size_t)g * 65536, 0, nullptr, r % I_POOL, lane); continue; } r -= 4 * I_POOL;
        if (r < I_W2) { tr_item(A.in[15], 64, 64, (bf16*)(ws + WS_W2T), 0, nullptr, r, lane); continue; } r -= I_W2;
        tr_item(A.in[18], 64, 64, (bf16*)(ws + WS_W2T) + 4096, 0, nullptr, r, lane);
    }
    { GAS v4u* z = (GAS v4u*)(ws + WS_WIN_T + (size_t)2328 * DM * 2); const int n16 = (NIN - 2328) * DM * 2 / 16;
      for (int i = gw * 64 + lane; i < n16; i += NGW * 64) z[i] = (v4u){0u, 0u, 0u, 0u}; }
    for (int idx = gw * 64 + lane; idx < 2 * 16 * 4 * 4 * 64; idx += NGW * 64) {
        const int ln = idx & 63, nbq = (idx >> 6) & 3, ds = (idx >> 8) & 3, l = (idx >> 10) & 15, kv = idx >> 14;
        const float* w1 = A.in[kv ? 17 : 14]; const int r = ln & 31, h = ln >> 5, lp = 16 * (nbq >> 1) + l, e = 32 * (nbq & 1) + r;
        float f[8];
#pragma unroll
        for (int j = 0; j < 8; ++j) f[j] = w1[((size_t)lp * 64 + 16 * ds + 8 * h + j) * 64 + e];
        v4u o; o.x = pk2(f[0], f[1]); o.y = pk2(f[2], f[3]); o.z = pk2(f[4], f[5]); o.w = pk2(f[6], f[7]);
        *((GAS v4u*)(ws + WS_W1F) + idx) = o;
    }
    if (vcu < 32) {
        LAS float* red = (LAS float*)(lds + 12288);
        const int o = tid & 127, part = tid >> 7, kv = o >> 6, e = o & 63; const float* pos = A.in[kv ? 16 : 13]; const float* w1 = A.in[kv ? 17 : 14];
        float s = 0.f; const int k0 = vcu * 64 + part * 16;
#pragma unroll
        for (int k = 0; k < 16; ++k) s += pos[k0 + k] * w1[(size_t)(k0 + k) * 64 + e];
        red[tid] = s; __syncthreads();
        if (tid < 128) { const float part = (red[tid] + red[tid + 128]) + (red[tid + 256] + red[tid + 384]);
            __hip_atomic_fetch_add((long long*)(ws + WS_POSTQ) + tid, (long long)__builtin_rintf(part * 1099511627776.0f), __ATOMIC_RELAXED, __HIP_MEMORY_SCOPE_AGENT); }
        __syncthreads();
    }
    for (int i = gw * 64 + lane; i < NB * 128 + SB * 128; i += NGW * 64) {
        if (i < NB * 128) { const int b = i >> 7, c = i & 127; ((bf16*)(ws + WS_KCMP_P))[((size_t)b * 256 + 255) * 128 + c] = 0; ((bf16*)(ws + WS_VCMP_P))[((size_t)b * 256 + 255) * 128 + c] = 0; }
        else { const int j = i - NB * 128, b = j >> 7, c = j & 127; ((float*)(ws + WS_KCMP_S))[((size_t)b * 1024 + 1023) * 128 + c] = 0.f; ((float*)(ws + WS_VCMP_S))[((size_t)b * 1024 + 1023) * 128 + c] = 0.f; }
    }
    for (int m = 8 * gw; m < MP; m += 8 * NGW) {
        const float* xr[8]; bf16* orow[8];
#pragma unroll
        for (int q = 0; q < 8; ++q) { xr[q] = A.in[0] + (size_t)(m + q) * DM; orow[q] = (bf16*)(ws + WS_H0) + (size_t)(m + q) * DM; }
        rms_rows_to_bf16<8>(xr, A.in[8], orow, lane); }
    if (gw < SB) { const float* xr[1] = {A.in[1] + (size_t)gw * DM}; bf16* orow[1] = {(bf16*)(ws + WS_HS0) + (size_t)gw * DM}; rms_rows_to_bf16<1>(xr, A.in[8], orow, lane); }
}

template <int NBK, class RowBase, class Epi>
__device__ __forceinline__ void skinny_gemm(LAS unsigned char* lds, const bf16* A0, int lda, int acol_per_task16  , const bf16* Bt, int K, int ntasks, int first, int stride, const RowBase& rowbase, const Epi& epi, int tid) {
    const int lane = tid & 63, w = tid >> 6, wu = __builtin_amdgcn_readfirstlane(tid >> 6), ks = K >> 3;
    LAS float* part = (LAS float*)lds;
    for (int task = first; task < ntasks; task += stride) {
        f32x4 acc[2][NBK];
#pragma unroll
        for (int i = 0; i < 2; ++i)
#pragma unroll
            for (int j = 0; j < NBK; ++j) acc[i][j] = (f32x4){0.f, 0.f, 0.f, 0.f};
        const bf16* A = A0 + (size_t)(task >> 4) * acol_per_task16;
        int rb[NBK];
#pragma unroll
        for (int j = 0; j < NBK; ++j) rb[j] = rowbase(task, j);
        const int kq = 8 * (lane >> 4), rl = lane & 15;
        constexpr int BQ = (NBK == 1) ? 11 : 4;
        const int kbeg = wu * ks, kend = kbeg + ks;
#pragma unroll 1
        for (int k = kbeg; k < kend; k += 32 * BQ) {
            bf16x8 a0v[BQ], a1v[BQ], bv[BQ][NBK];
#pragma unroll
            for (int q = 0; q < BQ; ++q) { const int kk = k + 32 * q;
                if (kk < kend) { a0v[q] = *(const GAS bf16x8*)(A + (size_t)rl * lda + kk + kq); a1v[q] = *(const GAS bf16x8*)(A + (size_t)(16 + rl) * lda + kk + kq);
#pragma unroll
                    for (int j = 0; j < NBK; ++j) bv[q][j] = *(const GAS bf16x8*)(Bt + (size_t)(rb[j] + rl) * K + kk + kq); } }
#pragma unroll
            for (int q = 0; q < BQ; ++q) { const int kk = k + 32 * q;
                if (kk < kend) {
#pragma unroll
                    for (int j = 0; j < NBK; ++j) { acc[0][j] = __builtin_amdgcn_mfma_f32_16x16x32_bf16(a0v[q], bv[q][j], acc[0][j], 0, 0, 0); acc[1][j] = __builtin_amdgcn_mfma_f32_16x16x32_bf16(a1v[q], bv[q][j], acc[1][j], 0, 0, 0); } } }
        }
#pragma unroll
        for (int i = 0; i < 2; ++i)
#pragma unroll
            for (int j = 0; j < NBK; ++j) *(LAS f32x4*)(part + (((w * 2 + i) * NBK + j) * 64 + lane) * 4) = acc[i][j];
        __syncthreads();
        { const int i = tid >> 8, ln = (tid >> 2) & 63, reg = tid & 3; float v[NBK];
#pragma unroll
          for (int j = 0; j < NBK; ++j) { float s = 0.f;
#pragma unroll
              for (int ww = 0; ww < 8; ++ww) s += part[(((ww * 2 + i) * NBK + j) * 64 + ln) * 4 + reg];
              v[j] = s; }
          epi(task, 16 * i + (ln >> 4) * 4 + reg, ln & 15, v); }
        __syncthreads();
    }
}
__device__ __forceinline__ void skinny_rowss(float v2, float* rowss_s, int s, int tid) {
    v2 += __shfl_xor(v2, 4); v2 += __shfl_xor(v2, 8); v2 += __shfl_xor(v2, 16); v2 += __shfl_xor(v2, 32);
    if ((tid & 60) == 0) atomic_addf(rowss_s + s, v2);
}

__device__ __forceinline__ void compress_wgtask(const Args& A, LAS unsigned char* lds, int wgtask, int wave, int lane, bool act) {
    asm volatile("" : "+v"(lane));
    LAS unsigned char* wlds = lds + wave * 8192; LAS unsigned char* bring = lds + 65536;
    const bool SAMPLE = wgtask < 552;
    int kv, local; if (SAMPLE) { kv = wgtask / 276; local = (wgtask % 276) * 8 + wave; } else { const int p = wgtask - 552; kv = p / 17; local = (p % 17) * 8 + wave; }
    const int TPS = SAMPLE ? 69 : 17, NCH = SAMPLE ? NCH_S : NCH_P, NBLK = SAMPLE ? NBLK_S : NBLK_P;
    const int tile = local % TPS, b = local / TPS;
    const int n0 = tile * 15, r = lane & 31, h = lane >> 5;
    unsigned char* ws = A.ws;
    const float* src = SAMPLE ? A.in[2] : (const float*)(A.out + O_CMP_P);
    unsigned eoff[8];
#pragma unroll
    for (int i = 0; i < 8; ++i) { const int rr = 4 * i + (lane >> 4), g = rr & 1; int n = n0 + (rr >> 1); n = n < NCH ? n : NCH - 1;
        unsigned rowbase;
        if (SAMPLE) { const int page = ((const int*)A.in[7])[b * NPAGE + (n >> 3)]; rowbase = (unsigned)(page * PAGE + (n & 7) * 16); } else rowbase = (unsigned)(b * SEQ + n * 16);
        eoff[i] = rowbase * 256u + (unsigned)((kv * 2 + g) * 64 + ((lane & 15) << 2)); }
    const GAS v4u* W1F = (const GAS v4u*)(ws + WS_W1F) + (size_t)kv * 16384 + lane;
    f32x16 acc[4];
#pragma unroll
    for (int j = 0; j < 4; ++j)
#pragma unroll
        for (int e = 0; e < 16; ++e) acc[j][e] = 0.f;
    f32x4 abuf[3][8];
#define CB_ISSUE(L, SET) do { \
        __builtin_amdgcn_global_load_lds((const unsigned*)(W1F + (size_t)((L) * 16 + 2 * wave) * 64), (LAS unsigned*)(bring + ((L) & 3) * 16384 + (2 * wave) * 1024), 16, 0, 0); \
        __builtin_amdgcn_global_load_lds((const unsigned*)(W1F + (size_t)((L) * 16 + 2 * wave + 1) * 64), (LAS unsigned*)(bring + ((L) & 3) * 16384 + (2 * wave + 1) * 1024), 16, 0, 0); \
        if (act) { _Pragma("unroll") for (int i = 0; i < 8; ++i) abuf[SET][i] = *(const GAS f32x4*)(src + (size_t)(eoff[i] + (unsigned)(L) * 256u)); } } while (0)
    asm volatile("s_waitcnt lgkmcnt(0)\n\ts_barrier" ::: "memory");
    CB_ISSUE(0, 0); CB_ISSUE(1, 1); CB_ISSUE(2, 2);
    const int wq = lane & 15, wsl = (wq >> 1), whalf = (wq & 1) * 8;
#define CB_STEP(L, SET) do { const int l_ = (L); \
        if (act) { \
        if (l_ <= 13) asm volatile("s_waitcnt vmcnt(20) lgkmcnt(0)\n\ts_barrier" ::: "memory"); \
        else if (l_ == 14) asm volatile("s_waitcnt vmcnt(10) lgkmcnt(0)\n\ts_barrier" ::: "memory"); \
        else asm volatile("s_waitcnt vmcnt(0) lgkmcnt(0)\n\ts_barrier" ::: "memory");                 \
        } else {                                                                                        \
        if (l_ <= 13) asm volatile("s_waitcnt vmcnt(4) lgkmcnt(0)\n\ts_barrier" ::: "memory"); \
        else if (l_ == 14) asm volatile("s_waitcnt vmcnt(2) lgkmcnt(0)\n\ts_barrier" ::: "memory"); \
        else asm volatile("s_waitcnt vmcnt(0) lgkmcnt(0)\n\ts_barrier" ::: "memory"); } \
        if (act) { _Pragma("unroll") for (int i = 0; i < 8; ++i) { const int rr = 4 * i + (lane >> 4); const f32x4 x = abuf[SET][i]; \
            u32x2 wv; wv.x = pg8::cvt_pk_bf16(x[0], x[1]); wv.y = pg8::cvt_pk_bf16(x[2], x[3]); \
            *(LAS u32x2*)(wlds + rr * 128 + ((wsl ^ ((rr >> 1) & 7)) << 4) + whalf) = wv; } } \
        if (l_ + 3 < 16) CB_ISSUE(l_ + 3, SET); \
        if (act) { \
        asm volatile("s_waitcnt lgkmcnt(0)" ::: "memory"); \
        const LAS unsigned char* bs = bring + (l_ & 3) * 16384; \
        _Pragma("unroll") for (int ds = 0; ds < 4; ++ds) { \
            const bf16x8 af = *(const LAS bf16x8*)(wlds + r * 128 + (((2 * ds + h) ^ ((r >> 1) & 7)) << 4)); \
            _Pragma("unroll") for (int nbq = 0; nbq < 4; ++nbq) { const v4u bfr = *(const LAS v4u*)(bs + ((ds * 4 + nbq) * 64 + lane) * 16); \
                acc[nbq] = __builtin_amdgcn_mfma_f32_32x32x16_bf16(af, __builtin_bit_cast(bf16x8, bfr), acc[nbq], 0, 0, 0); } \
            __builtin_amdgcn_sched_barrier(0); } } \
    } while (0)
#pragma unroll 1
    for (int l3 = 0; l3 < 15; l3 += 3) { CB_STEP(l3, 0); CB_STEP(l3 + 1, 1); CB_STEP(l3 + 2, 2); }
    CB_STEP(15, 0);
#undef CB_STEP
#undef CB_ISSUE
    asm volatile("s_waitcnt lgkmcnt(0)" ::: "memory");
    if (!act) return;
    LAS float* P1 = (LAS float*)wlds;
#pragma unroll
    for (int q = 0; q < 2; ++q)
#pragma unroll
        for (int reg = 0; reg < 16; ++reg) P1[((reg & 3) + 8 * (reg >> 2) + 4 * h) * 64 + 32 * q + r] = acc[2 + q][reg];
    LDS_WAIT(); asm volatile("" ::: "memory");
    const long long* post = (const long long*)(ws + WS_POSTQ) + kv * 64;
    const float pt0 = (float)post[r] * 9.094947017729282e-13f, pt1 = (float)post[32 + r] * 9.094947017729282e-13f;
#pragma unroll
    for (int q = 0; q < 2; ++q)
#pragma unroll
        for (int reg = 0; reg < 16; ++reg) { const int row = (reg & 3) + 8 * (reg >> 2) + 4 * h; const int rn = row < 30 ? row + 2 : 31;
            const float x = acc[q][reg] + P1[rn * 64 + 32 * q + r] + (q ? pt1 : pt0);
            const float t = x + 0.044715f * x * x * x;
            acc[q][reg] = x * frcp(1.0f + fexp2(-2.3022082f * t)); }
    LDS_WAIT(); asm volatile("" ::: "memory");
    LAS bf16* HB = (LAS bf16*)wlds;
#pragma unroll
    for (int q = 0; q < 2; ++q)
#pragma unroll
        for (int reg = 0; reg < 16; ++reg) HB[((reg & 3) + 8 * (reg >> 2) + 4 * h) * 72 + 32 * q + r] = (bf16)f2bf(acc[q][reg]);
    LDS_WAIT(); asm volatile("" ::: "memory");
    f32x16 o2[2];
#pragma unroll
    for (int j = 0; j < 2; ++j)
#pragma unroll
        for (int e = 0; e < 16; ++e) o2[j][e] = 0.f;
    const bf16* W2T = (const bf16*)(ws + WS_W2T) + kv * 4096;
#pragma unroll
    for (int ksq = 0; ksq < 4; ++ksq) {
        const bf16x8 a0 = *(const LAS bf16x8*)(HB + r * 72 + 16 * ksq + 8 * h);
#pragma unroll
        for (int q = 0; q < 2; ++q) { const bf16x8 bfr2 = *(const GAS bf16x8*)(W2T + (32 * q + r) * 64 + 16 * ksq + 8 * h);
            o2[q] = __builtin_amdgcn_mfma_f32_32x32x16_bf16(a0, bfr2, o2[q], 0, 0, 0); }
    }
    LDS_WAIT(); asm volatile("" ::: "memory");
#pragma unroll
    for (int q = 0; q < 2; ++q)
#pragma unroll
        for (int reg = 0; reg < 16; ++reg) { const int row = (reg & 3) + 8 * (reg >> 2) + 4 * h, n = n0 + (row >> 1), g = row & 1;
            if (row < 30 && n < NBLK) {
                if (SAMPLE) ((float*)(ws + (kv ? WS_VCMP_S : WS_KCMP_S)))[((size_t)(b * 1024 + n) * 2 + g) * 64 + 32 * q + r] = o2[q][reg];
                else ((bf16*)(ws + (kv ? WS_VCMP_P : WS_KCMP_P)))[((size_t)(b * 256 + n) * 2 + g) * 64 + 32 * q + r] = (bf16)f2bf(o2[q][reg]); } }
}

__device__ __forceinline__ void conv_ln_rows(const Args& A, LAS float* ybuf  , int nrows, bf16* mix_base  , int tid) {
    const int lane = tid & 63, w = tid >> 6;
    const float* lg = A.in[21]; const float* lb = A.in[22];
    f32x4 g0 = *(const GAS f32x4*)(lg + 8 * lane), g1 = *(const GAS f32x4*)(lg + 8 * lane + 4), b0 = *(const GAS f32x4*)(lb + 8 * lane), b1 = *(const GAS f32x4*)(lb + 8 * lane + 4);
    const int rpw = (nrows + 7) >> 3;
    for (int rr = 0; rr < rpw; ++rr) { const int row = rpw * w + rr; if (row >= nrows) break;
        f32x4 y0 = *(const LAS f32x4*)(ybuf + row * 512 + 8 * lane), y1 = *(const LAS f32x4*)(ybuf + row * 512 + 8 * lane + 4);
        const float mu = wave_sum((y0[0] + y0[1]) + (y0[2] + y0[3]) + (y1[0] + y1[1]) + (y1[2] + y1[3])) * (1.0f / CCH);
        y0 -= mu; y1 -= mu;
        const float var = wave_sum((y0[0] * y0[0] + y0[1] * y0[1]) + (y0[2] * y0[2] + y0[3] * y0[3]) + (y1[0] * y1[0] + y1[1] * y1[1]) + (y1[2] * y1[2] + y1[3] * y1[3])) * (1.0f / CCH);
        const float rstd = 1.0f / sqrtf(var + EPS);
        f32x4 z0 = y0 * rstd * g0 + b0, z1 = y1 * rstd * g1 + b1;
#pragma unroll
        for (int e = 0; e < 4; ++e) { z0[e] = z0[e] * sigmoidf_(z0[e]); z1[e] = z1[e] * sigmoidf_(z1[e]); }
        *(GAS v4u*)(mix_base + (size_t)row * DM + 8 * lane) = pack8(z0, z1); }
}
__device__ __forceinline__ void conv_unit_prompt(const Args& A, LAS unsigned char* lds, int unit, int tid) {
    asm volatile("" : "+v"(tid));
    const int b = unit >> 6, half = tid >> 8, c = 2 * (tid & 255), t0 = (unit & 63) * 64 + 32 * half;
    const bf16* a = (const bf16*)(A.ws + WS_AGLU) + (size_t)b * SEQ * CCH + c;
    const float* cw = A.in[19] + c; f32x2 w[CONVW];
#pragma unroll
    for (int k = 0; k < CONVW; ++k) w[k] = *(const GAS f32x2*)(cw + k * CCH);
    const f32x2 bias = *(const GAS f32x2*)(A.in[20] + c);
    unsigned raw[64];
#pragma unroll
    for (int i = 0; i < 64; ++i) { const int t = t0 - 32 + i; raw[i] = *(const GAS unsigned*)(a + (size_t)(t >= 0 ? t : 0) * CCH); }
    f32x2 win[32];
#pragma unroll
    for (int i = 0; i < 32; ++i) { const int t = t0 - 32 + i; win[i] = (t >= 0) ? (f32x2){bflo(raw[i]), bfhi(raw[i])} : (f32x2){0.f, 0.f}; }
    LAS float* ybuf = (LAS float*)lds + (size_t)half * 32 * 512;
#pragma unroll
    for (int i = 0; i < 32; ++i) { win[i] = (f32x2){bflo(raw[32 + i]), bfhi(raw[32 + i])};
        f32x2 y = bias;
#pragma unroll
        for (int k = 0; k < CONVW; ++k) y += w[k] * win[(i - 30 + k) & 31];
        *(LAS f32x2*)(ybuf + i * 512 + c) = y; }
    __syncthreads();
    conv_ln_rows(A, (LAS float*)lds, 64, (bf16*)(A.ws + WS_MIX) + (size_t)(b * SEQ + (unit & 63) * 64) * DM + 512, tid);
    __syncthreads();
}
__device__ __forceinline__ void conv_unit_sample(const Args& A, LAS unsigned char* lds, int s, int tid) {
    asm volatile("" : "+v"(tid));
    const int c = tid; const float* zs = (const float*)(A.ws + WS_ZS) + (size_t)s * NIN;
    const int R1 = 1280 + (c >> 7) * 256 + (c & 127);
    const float anew = zs[R1] * sigmoidf_(zs[R1 + 128]);
    const float* st = A.in[5] + (size_t)s * 30 * CCH + c; const float* cw = A.in[19] + c;
    float y = A.in[20][c]; float* oc = A.out + O_CONV_S + (size_t)s * 30 * CCH + c;
    float e[30], wv[31];
#pragma unroll
    for (int k = 0; k < 30; ++k) { e[k] = *(const GAS float*)(st + k * CCH); wv[k] = *(const GAS float*)(cw + k * CCH); }
    wv[30] = *(const GAS float*)(cw + 30 * CCH);
#pragma unroll
    for (int k = 0; k < 30; ++k) { y += wv[k] * e[k]; if (k >= 1) *(GAS float*)(oc + (k - 1) * CCH) = e[k]; }
    y += wv[30] * anew; oc[29 * CCH] = anew;
    LAS float* ybuf = (LAS float*)lds; ybuf[c] = y;
    __syncthreads();
    conv_ln_rows(A, ybuf, 1, (bf16*)(A.ws + WS_MIXS) + (size_t)s * DM + 512, tid);
    __syncthreads();
}

__device__ __forceinline__ void pool_prep_unit(const Args& A, int unit, int tid) {
    asm volatile("" : "+v"(tid));
    const int b = unit >> 6, t0 = (unit & 63) * 64, c = 2 * tid, gi = c >> 8;
    const bf16* XBp = (const bf16*)(A.ws + WS_XB) + (size_t)b * SEQ * DM + c; const float* rs = (const float*)(A.ws + WS_ROWSS) + 1 * RS_STRIDE + b * SEQ;
    bf16* Z = (bf16*)(A.ws + WS_Z) + (size_t)b * SEQ * DM + c;
    const f32x2 g = *(const GAS f32x2*)(A.in[8] + DM + c);
    const float wl = (float)(2 << gi);
    f32x2 win[16];
#pragma unroll
    for (int i = 0; i < 16; ++i) win[i] = (f32x2){0.f, 0.f};
    unsigned xw[16], xn[16]; float rv[16], rn[16];
#pragma unroll
    for (int i = 0; i < 16; ++i) { const int t = t0 - 16 + i; const int tc = t >= 0 ? t : 0; xn[i] = *(const GAS unsigned*)(XBp + (size_t)tc * DM); rn[i] = *(const GAS float*)(rs + tc); }
#pragma unroll 1
    for (int blk = -1; blk < 4; ++blk) {
#pragma unroll
        for (int i = 0; i < 16; ++i) { xw[i] = xn[i]; rv[i] = rn[i]; }
        if (blk < 3) {
#pragma unroll
            for (int i = 0; i < 16; ++i) { const int t = t0 + (blk + 1) * 16 + i; xn[i] = *(const GAS unsigned*)(XBp + (size_t)t * DM); rn[i] = *(const GAS float*)(rs + t); } }
#pragma unroll
        for (int i = 0; i < 16; ++i) { const int t = t0 + blk * 16 + i;
            f32x2 h = (f32x2){0.f, 0.f};
            if (t >= 0) { const float rstd = __builtin_amdgcn_rsqf(rv[i] * (1.0f / DM) + EPS); h = (f32x2){bflo(xw[i]), bfhi(xw[i])} * rstd * g; }
            win[i] = h;
            if (blk >= 0) {
                f32x2 s2 = h + win[(i - 1) & 15];
                f32x2 s4 = s2 + win[(i - 2) & 15] + win[(i - 3) & 15];
                f32x2 s8 = s4 + (win[(i - 4) & 15] + win[(i - 5) & 15]) + (win[(i - 6) & 15] + win[(i - 7) & 15]);
                f32x2 s16 = s8 + ((win[(i - 8) & 15] + win[(i - 9) & 15]) + (win[(i - 10) & 15] + win[(i - 11) & 15])) + ((win[(i - 12) & 15] + win[(i - 13) & 15]) + (win[(i - 14) & 15] + win[(i - 15) & 15]));
                const f32x2 sw = gi == 0 ? s2 : gi == 1 ? s4 : gi == 2 ? s8 : s16;
                const float cnt = fminf(wl, (float)(t + 1));
                const f32x2 z = sw * (1.0f / cnt) - h;
                *(GAS unsigned*)(Z + (size_t)t * DM) = pg8::cvt_pk_bf16(z.x, z.y);
                if (t >= SEQ - POOLB) *(GAS f32x2*)(A.out + O_POOL_P + ((size_t)(b * POOLB + t - (SEQ - POOLB)) * DM + c)) = h;
            } }
    }
}
__device__ __forceinline__ void pool_prep_sample(const Args& A, int s, int tid) {
    asm volatile("" : "+v"(tid));
    const int c = 2 * tid, gi = c >> 8; const int wl = 2 << gi;
    const float rstd = __builtin_amdgcn_rsqf(((const float*)(A.ws + WS_ROWSS))[1 * RS_STRIDE + MP + s] * (1.0f / DM) + EPS);
    const f32x2 g = *(const GAS f32x2*)(A.in[8] + DM + c);
    const f32x2 h = *(const GAS f32x2*)((const float*)(A.ws + WS_XRS) + (size_t)s * DM + c) * rstd * g;
    const float* st = A.in[6] + (size_t)s * POOLB * DM + c; float* op = A.out + O_POOL_S + (size_t)s * POOLB * DM + c;
    f32x2 sw = h, e[POOLB];
#pragma unroll
    for (int k = 0; k < POOLB; ++k) e[k] = *(const GAS f32x2*)(st + (size_t)k * DM);
#pragma unroll
    for (int k = 0; k < POOLB; ++k) {
        if (15 - k < wl) sw += e[k];
        if (k >= 1) *(GAS f32x2*)(op + (size_t)(k - 1) * DM) = e[k]; }
    *(GAS f32x2*)(op + (size_t)(POOLB - 1) * DM) = h;
    const f32x2 z = sw * (1.0f / (float)wl) - h;
    *(GAS unsigned*)((bf16*)(A.ws + WS_ZPS) + (size_t)s * DM + c) = pg8::cvt_pk_bf16(z.x, z.y);
}
constexpr int PL_H = 0, PL_Z = 81920, PL_END = PL_Z + 32768;
static_assert(PL_END + 2048 <= RING_BYTES && 80 * 1024 <= PL_Z, "pooling LDS");
__device__ __forceinline__ void pool_fused_wg(const Args& A, LAS unsigned char* lds, int g, int wgi, int tid) {
    asm volatile("" : "+v"(tid));
    const int lane = tid & 63, wave = __builtin_amdgcn_readfirstlane(tid >> 6), r32 = lane & 31, hi = lane >> 5;
    unsigned char* ws = A.ws;
    const bf16* XBo = (const bf16*)(ws + WS_XB); bf16* XBn = (bf16*)(ws + WS_XR);
    float* rs_in = (float*)(ws + WS_ROWSS) + 1 * RS_STRIDE; float* rs_out = (float*)(ws + WS_ROWSS) + 2 * RS_STRIDE;
    LAS float* H = (LAS float*)(lds + PL_H); LAS unsigned char* Zt = lds + PL_Z;
    bf16x8 wf[16];
    { const bf16* wt = (const bf16*)(ws + WS_POOL_T) + (size_t)g * 65536 + (size_t)(32 * wave + r32) * 256 + 8 * hi;
#pragma unroll
      for (int ks = 0; ks < 16; ++ks) wf[ks] = *(const GAS bf16x8*)(wt + 16 * ks); }
    const int c8 = tid & 31;
    LAS float* GL = (LAS float*)(lds + PL_END);
    f32x4 glv = (f32x4){0.f, 0.f, 0.f, 0.f};
    if (tid < 64) glv = *(const GAS f32x4*)(A.in[8] + DM + g * 256 + 4 * tid);
    else if (tid < 128) glv = *(const GAS f32x4*)(A.in[24] + g * 256 + 4 * (tid - 64));
    const int w = 2 << g; const float invw = 1.0f / (float)w;
#define PL_BAR() asm volatile("s_waitcnt lgkmcnt(0)\n\ts_barrier" ::: "memory")
#define PL_SWZ(X) ss += __int_as_float(__builtin_amdgcn_ds_swizzle(__float_as_int(ss), ((X) << 10) | 0x1F))
    const int b = wgi >> 3, R0 = (wgi & 7) * 512, r16 = tid >> 5;
    const size_t rowb = (size_t)b * SEQ;
    const bf16* xcol = XBo + rowb * DM + g * 256 + 8 * c8; const float* rsb = rs_in + rowb;
    v4u pb[3][4]; float pr[3][4];
    const bf16* xld = xcol + (size_t)(R0 + r16) * DM; const float* rld = rsb + R0 + r16;
#define PL_LOAD(UU) do { asm volatile("" : "+v"(xld), "+v"(rld)); _Pragma("unroll") for (int j = 0; j < 4; ++j) { \
        pb[(UU) % 3][j] = *(const GAS v4u*)(xld + (size_t)(16 * j) * DM); pr[(UU) % 3][j] = *(const GAS float*)(rld + 16 * j); } xld += 64 * DM; rld += 64; } while (0)
    pb[2][3] = (v4u){0u, 0u, 0u, 0u}; pr[2][3] = 0.f;
    if (R0 > 0) { const int t = R0 - 16 + r16; pb[2][3] = *(const GAS v4u*)(xcol + (size_t)t * DM); pr[2][3] = *(const GAS float*)(rsb + t); }
    PL_LOAD(0); PL_LOAD(1);
    if (tid < 128) *(LAS f32x4*)(GL + 4 * tid) = glv;
    __syncthreads();
#pragma unroll
    for (int u = 0; u < 8; ++u) {
        const int R = R0 + 64 * u;
        { const f32x4 ga = *(const LAS f32x4*)(GL + 8 * c8), gb = *(const LAS f32x4*)(GL + 8 * c8 + 4);
          f32x4 h0 = (f32x4){0.f, 0.f, 0.f, 0.f}, h1 = h0;
          if (R > 0) { const v4u hal = pb[(u + 2) % 3][3]; const float rstd = __builtin_amdgcn_rsqf(pr[(u + 2) % 3][3] * (1.0f / DM) + EPS);
              h0 = (f32x4){bflo(hal.x), bfhi(hal.x), bflo(hal.y), bfhi(hal.y)} * rstd * ga; h1 = (f32x4){bflo(hal.z), bfhi(hal.z), bflo(hal.w), bfhi(hal.w)} * rstd * gb; }
          *(LAS f32x4*)(H + r16 * 256 + 8 * c8) = h0; *(LAS f32x4*)(H + r16 * 256 + 8 * c8 + 4) = h1;
#pragma unroll
          for (int j = 0; j < 4; ++j) { const int i = 16 + r16 + 16 * j; const v4u xw = pb[u % 3][j]; const float rstd = __builtin_amdgcn_rsqf(pr[u % 3][j] * (1.0f / DM) + EPS);
              h0 = (f32x4){bflo(xw.x), bfhi(xw.x), bflo(xw.y), bfhi(xw.y)} * rstd * ga; h1 = (f32x4){bflo(xw.z), bfhi(xw.z), bflo(xw.w), bfhi(xw.w)} * rstd * gb;
              *(LAS f32x4*)(H + i * 256 + 8 * c8) = h0; *(LAS f32x4*)(H + i * 256 + 8 * c8 + 4) = h1; } }
        if (u + 2 < 8) PL_LOAD(u + 2);
        PL_BAR();
        { int tq = tid; asm volatile("" : "+v"(tq));
          const int cp = tq & 127, rq = tq >> 7, i0 = 16 * rq + 16;
          f32x2 sacc = (f32x2){0.f, 0.f};
          { f32x2 iv[15];
#pragma unroll
            for (int d = 1; d < 16; ++d) iv[d - 1] = *(const LAS f32x2*)(H + (i0 - d) * 256 + 2 * cp);
            __builtin_amdgcn_sched_barrier(0);
            const f32x2 s1 = iv[0], s3 = s1 + (iv[1] + iv[2]), s7 = s3 + ((iv[3] + iv[4]) + (iv[5] + iv[6])), s15 = s7 + (((iv[7] + iv[8]) + (iv[9] + iv[10])) + ((iv[11] + iv[12]) + (iv[13] + iv[14])));
            sacc = (w == 2) ? s1 : (w == 4) ? s3 : (w == 8) ? s7 : s15; }
          const bool special = (u == 0 && R == 0) || (u == 7 && R == SEQ - 64);
          if (!special) {
              const LAS float* hb = H + i0 * 256 + 2 * cp; const LAS float* hs = hb - (w - 1) * 256;
              LAS unsigned char* zb = Zt + (16 * rq) * 512 + (cp & 3) * 4; const int cq = (cp >> 2) << 4;
#pragma unroll
              for (int kb = 0; kb < 16; kb += 8) { f32x2 hv[8], sv[8];
#pragma unroll
                  for (int k = 0; k < 8; ++k) { hv[k] = *(const LAS f32x2*)(hb + (kb + k) * 256); sv[k] = *(const LAS f32x2*)(hs + (kb + k) * 256); }
                  __builtin_amdgcn_sched_barrier(0);
#pragma unroll
                  for (int k = 0; k < 8; ++k) { sacc += hv[k];
                      const f32x2 z = sacc * invw - hv[k];
                      *(LAS unsigned*)(zb + (kb + k) * 512 + (cq ^ ((kb + k) << 4))) = pg8::cvt_pk_bf16(z.x, z.y);
                      sacc -= sv[k]; }
                  __builtin_amdgcn_sched_barrier(0); }
          } else {
#pragma unroll 8
          for (int k = 0; k < 16; ++k) { const int i = i0 + k, r = 16 * rq + k, t = R + r;
              const f32x2 h = *(const LAS f32x2*)(H + i * 256 + 2 * cp);
              sacc += h;
              const float cnt = fminf((float)w, (float)(t + 1));
              const f32x2 z = sacc * (1.0f / cnt) - h;
              *(LAS unsigned*)(Zt + r * 512 + ((((2 * cp) >> 3) ^ (r & 15)) << 4) + ((2 * cp) & 7) * 2) = pg8::cvt_pk_bf16(z.x, z.y);
              if (t >= SEQ - POOLB) *(GAS f32x2*)(A.out + O_POOL_P + ((size_t)(b * POOLB + t - (SEQ - POOLB)) * DM + g * 256 + 2 * cp)) = h;
              sacc -= *(const LAS f32x2*)(H + (i - w + 1) * 256 + 2 * cp); } } }
        PL_BAR();
        f32x16 acc[2];
#pragma unroll
        for (int e = 0; e < 16; ++e) { acc[0][e] = 0.f; acc[1][e] = 0.f; }
        { bf16x8 af[2][2];
#define PL_AF(KS) do { _Pragma("unroll") for (int rb = 0; rb < 2; ++rb) { const int row = 32 * rb + r32; af[(KS) & 1][rb] = *(const LAS bf16x8*)(Zt + row * 512 + (((2 * (KS) + hi) ^ (row & 15)) << 4)); } } while (0)
          PL_AF(0);
#pragma unroll
          for (int ks = 0; ks < 16; ++ks) {
              if (ks + 1 < 16) PL_AF(ks + 1);
              __builtin_amdgcn_sched_barrier(0);
#pragma unroll
              for (int rb = 0; rb < 2; ++rb) acc[rb] = __builtin_amdgcn_mfma_f32_32x32x16_bf16(af[ks & 1][rb], wf[ks], acc[rb], 0, 0, 0);
              __builtin_amdgcn_sched_barrier(0); }
#undef PL_AF
        }
#pragma unroll
        for (int rb = 0; rb < 2; ++rb)
#pragma unroll
            for (int e = 0; e < 16; ++e) H[(32 * rb + (e & 3) + 8 * (e >> 2) + 4 * hi) * 256 + 32 * wave + r32] = acc[rb][e];
        PL_BAR();
        { const f32x4 sa = *(const LAS f32x4*)(GL + 256 + 8 * c8), sb = *(const LAS f32x4*)(GL + 256 + 8 * c8 + 4);
          float ssv[4];
#pragma unroll
          for (int j = 0; j < 4; ++j) { const int row = r16 + 16 * j; const size_t off = (rowb + R + row) * DM + g * 256 + 8 * c8;
            const v4u xw = pb[u % 3][j];
            const f32x4 p0 = *(const LAS f32x4*)(H + row * 256 + 8 * c8), p1 = *(const LAS f32x4*)(H + row * 256 + 8 * c8 + 4);
            const f32x4 v0 = (f32x4){bflo(xw.x), bfhi(xw.x), bflo(xw.y), bfhi(xw.y)} + p0 * sa, v1 = (f32x4){bflo(xw.z), bfhi(xw.z), bflo(xw.w), bfhi(xw.w)} + p1 * sb;
            *(GAS v4u*)(XBn + off) = pack8(v0, v1);
            ssv[j] = (v0[0] * v0[0] + v0[1] * v0[1]) + (v0[2] * v0[2] + v0[3] * v0[3]) + (v1[0] * v1[0] + v1[1] * v1[1]) + (v1[2] * v1[2] + v1[3] * v1[3]); }
#define PL_LVL(X) do { float tv[4]; _Pragma("unroll") for (int j = 0; j < 4; ++j) tv[j] = __int_as_float(__builtin_amdgcn_ds_swizzle(__float_as_int(ssv[j]), ((X) << 10) | 0x1F)); \
                       _Pragma("unroll") for (int j = 0; j < 4; ++j) ssv[j] += tv[j]; } while (0)
          PL_LVL(1); PL_LVL(2); PL_LVL(4); PL_LVL(8); PL_LVL(16);
#undef PL_LVL
          if (c8 == 0) {
#pragma unroll
              for (int j = 0; j < 4; ++j) atomic_addf(rs_out + rowb + R + r16 + 16 * j, ssv[j]); } }
        PL_BAR();
    }
    __syncthreads();
#undef PL_LOAD
#undef PL_BAR
#undef PL_SWZ
}
__device__ __forceinline__ void final_row(const float* xrow, float ss, const float* gain, float* orow, int lane) {
    const float rstd = 1.0f / sqrtf(ss * (1.0f / DM) + EPS);
    const GAS f32x4* xr = (const GAS f32x4*)xrow + lane; const GAS f32x4* gr = (const GAS f32x4*)gain + lane; GAS f32x4* o = (GAS f32x4*)orow + lane;
    f32x4 xv[4], gv[4];
#pragma unroll
    for (int j = 0; j < 4; ++j) { xv[j] = xr[64 * j]; gv[j] = gr[64 * j]; }
#pragma unroll
    for (int j = 0; j < 4; ++j) o[64 * j] = xv[j] * rstd * gv[j];
}
__device__ __forceinline__ void final_row_bf16(const bf16* xrow, float ss, const float* gain, float* orow, int lane) {
    const float rstd = 1.0f / sqrtf(ss * (1.0f / DM) + EPS);
    const GAS v4u* xr = (const GAS v4u*)xrow + lane; const GAS f32x4* gr = (const GAS f32x4*)gain + 2 * lane; GAS f32x4* o = (GAS f32x4*)orow + 2 * lane;
#pragma unroll
    for (int j = 0; j < 2; ++j) { const v4u w = xr[64 * j];
        o[128 * j] = (f32x4){bflo(w.x), bfhi(w.x), bflo(w.y), bfhi(w.y)} * rstd * gr[128 * j]; o[128 * j + 1] = (f32x4){bflo(w.z), bfhi(w.z), bflo(w.w), bfhi(w.w)} * rstd * gr[128 * j + 1]; }
}

constexpr int AT_KV = 0, AT_KVB = 16640  , AT_SLOT = 16384  ,
              AT_WSF = 4 * AT_SLOT, AT_SA = AT_WSF + 2048, AT_SB = AT_SA + 64 * 65 * 4, AT_SS = AT_SB + 64 * 65 * 4,
              AT_SEL = AT_SS + 64 * 64 * 4, AT_END = AT_SA + 8 * 8192;
static_assert(AT_END <= RING_BYTES && AT_SEL + 512 <= AT_END, "attention LDS");
__device__ __forceinline__ int crow(int r, int hi) { return (r & 3) + 8 * (r >> 2) + 4 * hi; }
__device__ __forceinline__ float xhalf_max(float m) { auto rr = __builtin_amdgcn_permlane32_swap(__float_as_uint(m), __float_as_uint(m), false, false); return fmaxf(__uint_as_float(rr[0]), __uint_as_float(rr[1])); }
__device__ __forceinline__ float xhalf_sum(float m) { auto rr = __builtin_amdgcn_permlane32_swap(__float_as_uint(m), __float_as_uint(m), false, false); return __uint_as_float(rr[0]) + __uint_as_float(rr[1]); }
typedef short v4i16_t __attribute__((ext_vector_type(4)));
__device__ __forceinline__ s16x4 vtr(const LAS unsigned char* p) { return __builtin_bit_cast(s16x4, __builtin_amdgcn_ds_read_tr16_b64_v4i16((LAS v4i16_t*)p)); }

struct KVTile { v4u k, v; };
__device__ __forceinline__ KVTile kv_gload(const bf16* Kg, const bf16* Vg, int pitch, int row0, int tid) {
    const int key = tid >> 3, c = tid & 7; KVTile t;
    t.k = *(const GAS v4u*)(Kg + (size_t)(row0 + key) * pitch + c * 8); t.v = *(const GAS v4u*)(Vg + (size_t)(row0 + key) * pitch + c * 8); return t;
}
__device__ __forceinline__ void kv_lwrite(LAS unsigned char* buf, const KVTile& t, int tid) {
    const int key = tid >> 3, c = tid & 7;
    *(LAS v4u*)(buf + c * 1040 + key * 16) = t.k;
    *(LAS v4u*)(buf + 8320 + (c >> 2) * 4160 + key * 64 + (c & 3) * 16) = t.v;
}
struct SmState { float m, l; bool seen; };
template <int MODE>
__device__ __forceinline__ void attn_tile(const LAS unsigned char* buf, const bf16x8 (&qf)[4], SmState& S, f32x16 (&o)[2], int lo, int hi_, bool tilefull, float invl,
                                         LAS float* wsf, LAS float* sA, LAS float* sB, int jbase, int qrow, int lane) {
    const int r32 = lane & 31, hi = lane >> 5;
    const bool laneon = hi_ >= lo;
    const float cinit = (MODE == 1) ? -S.m : (laneon ? -S.m : -INFINITY);
    f32x16 p0, p1; int c0t;
#pragma unroll
    for (int e = 0; e < 16; ++e) { p0[e] = cinit; p1[e] = cinit; }
#pragma unroll
    for (int s = 0; s < 4; ++s) {
        const int sw_ = (r32 >> 1) & 7;
        const bf16x8 k0 = *(const LAS bf16x8*)(buf + r32 * 128 + (((2 * s + hi) ^ sw_) << 4)), k1 = *(const LAS bf16x8*)(buf + (32 + r32) * 128 + (((2 * s + hi) ^ sw_) << 4));
        p0 = __builtin_amdgcn_mfma_f32_32x32x16_bf16(k0, qf[s], p0, 0, 0, 0); p1 = __builtin_amdgcn_mfma_f32_32x32x16_bf16(k1, qf[s], p1, 0, 0, 0);
    }
    if (!tilefull) {
        const int lo2 = laneon ? lo : 64, R = laneon ? hi_ - lo : 0, kb0 = 4 * hi - lo2; const float ninf = -INFINITY;
#pragma unroll
        for (int e = 0; e < 16; ++e) { const int c0 = (e & 3) + 8 * (e >> 2);
            asm volatile("v_add_u32 %0, %2, %3\n\tv_cmp_gt_u32 vcc, %0, %4\n\tv_cndmask_b32 %1, %1, %5, vcc" : "=&v"(c0t), "+v"(p0[e]) : "v"(kb0), "n"(c0), "v"(R), "v"(ninf) : "vcc");
            asm volatile("v_add_u32 %0, %2, %3\n\tv_cmp_gt_u32 vcc, %0, %4\n\tv_cndmask_b32 %1, %1, %5, vcc" : "=&v"(c0t), "+v"(p1[e]) : "v"(kb0), "n"(c0 + 32), "v"(R), "v"(ninf) : "vcc"); }
    }
    if (MODE != 1) {
        float rm = fmaxf(p0[0], p1[0]);
#pragma unroll
        for (int e = 1; e < 16; ++e) rm = fmaxf(rm, fmaxf(p0[e], p1[e]));
        rm = xhalf_max(rm);
        const bool valid = rm > -INFINITY;
        const bool need = S.seen ? (rm > 8.0f) : (valid && (rm > 8.0f || rm < -8.0f));
        if (__any(need)) {
            float dl = 0.f, f = 1.f;
            if (valid) { if (!S.seen) dl = rm; else if (rm > 0.f) { dl = rm; f = fexp2(-dl); } }
            S.m += dl; S.l *= f;
#pragma unroll
            for (int e = 0; e < 16; ++e) { p0[e] -= dl; p1[e] -= dl; }
            if (MODE == 2) {
                if (hi == 0) wsf[r32] = f;
                LDS_WAIT(); asm volatile("" ::: "memory");
#pragma unroll
                for (int e = 0; e < 16; ++e) { const float fr_ = wsf[crow(e, hi)]; o[0][e] *= fr_; o[1][e] *= fr_; }
                LDS_WAIT(); asm volatile("" ::: "memory");
            }
        }
        S.seen = S.seen || valid;
    }
    float ls = 0.f;
#pragma unroll
    for (int e = 0; e < 16; ++e) { p0[e] = fexp2(p0[e]); p1[e] = fexp2(p1[e]); ls += p0[e] + p1[e]; }
    if (MODE != 1) S.l += ls;
    if (MODE == 0) return;
    if (MODE == 1) {
#pragma unroll
        for (int e = 0; e < 16; ++e) { p0[e] *= invl; p1[e] *= invl; }
#pragma unroll
        for (int kb = 0; kb < 2; ++kb)
#pragma unroll
            for (int i = 0; i < 4; ++i) { const f32x16& p = kb ? p1 : p0;
                float a = 2.0f * (p[4 * i] + p[4 * i + 1] + p[4 * i + 2]) + p[4 * i + 3], bq = p[4 * i + 3];
                a += __shfl_xor(a, 1); a += __shfl_xor(a, 2); bq += __shfl_xor(bq, 1); bq += __shfl_xor(bq, 2);
                const int j = jbase + 8 * kb + 2 * i + hi;
                if ((lane & 3) == 0) { sA[qrow * 65 + j] = a; sB[qrow * 65 + j + 1] = bq; } }
    }
    bf16x8 pa[4];
#pragma unroll
    for (int ks = 0; ks < 4; ++ks) { const f32x16& p = (ks >> 1) ? p1 : p0; const int b8 = 8 * (ks & 1);
        v4u w; w.x = pg8::cvt_pk_bf16(p[b8], p[b8 + 1]); w.y = pg8::cvt_pk_bf16(p[b8 + 2], p[b8 + 3]); w.z = pg8::cvt_pk_bf16(p[b8 + 4], p[b8 + 5]); w.w = pg8::cvt_pk_bf16(p[b8 + 6], p[b8 + 7]);
        pa[ks] = __builtin_bit_cast(bf16x8, w); }
    const LAS unsigned char* vb = buf + 8192 + ((lane >> 4) & 1) * 32 + (lane & 3) * 8 + (4 * hi + ((lane & 15) >> 2)) * 64;
#pragma unroll
    for (int d0 = 0; d0 < 2; ++d0)
#pragma unroll
        for (int ks = 0; ks < 4; ++ks) { const s16x4 vl = vtr(vb + d0 * 4096 + ks * 1024), vh = vtr(vb + d0 * 4096 + ks * 1024 + 512);
            const bf16x8 vf = (bf16x8){vl[0], vl[1], vl[2], vl[3], vh[0], vh[1], vh[2], vh[3]};
            o[d0] = __builtin_amdgcn_mfma_f32_32x32x16_bf16(pa[ks], vf, o[d0], 0, 0, 0); }
}
template <int PITCH = 256>
__device__ __forceinline__ void kv_dma(const bf16* Kg, const bf16* Vg, int row0, LAS unsigned char* slot, int w, int lane) {
    const int kkey = 8 * w + (lane >> 3), kc = (lane & 7) ^ ((kkey >> 1) & 7);
    __builtin_amdgcn_global_load_lds((const unsigned*)(Kg + (size_t)(row0 + kkey) * PITCH + kc * 8), (LAS unsigned*)(slot + w * 1024), 16, 0, 0);
    const int vkey = 16 * (w & 3) + (lane >> 2);
    __builtin_amdgcn_global_load_lds((const unsigned*)(Vg + (size_t)(row0 + vkey) * PITCH + (w >> 2) * 32 + (lane & 3) * 8), (LAS unsigned*)(slot + 8192 + w * 1024), 16, 0, 0);
}
__device__ __forceinline__ void qk_ring(f32x16& p0, f32x16& p1, const LAS unsigned char* slot, const bf16x8 (&qf)[4], float mref, int r32, int hi) {
    const int sw = (r32 >> 1) & 7; f32x16 negm;
#pragma unroll
    for (int e = 0; e < 16; ++e) negm[e] = -mref;
#pragma unroll
    for (int s = 0; s < 4; ++s) {
        const bf16x8 k0 = *(const LAS bf16x8*)(slot + r32 * 128 + (((2 * s + hi) ^ sw) << 4)), k1 = *(const LAS bf16x8*)(slot + (32 + r32) * 128 + (((2 * s + hi) ^ sw) << 4));
        if (s == 0) { p0 = __builtin_amdgcn_mfma_f32_32x32x16_bf16(k0, qf[0], negm, 0, 0, 0); p1 = __builtin_amdgcn_mfma_f32_32x32x16_bf16(k1, qf[0], negm, 0, 0, 0); }
        else { p0 = __builtin_amdgcn_mfma_f32_32x32x16_bf16(k0, qf[s], p0, 0, 0, 0); p1 = __builtin_amdgcn_mfma_f32_32x32x16_bf16(k1, qf[s], p1, 0, 0, 0); }
    }
}
__device__ __forceinline__ float mask_max(f32x16& p0, f32x16& p1, bool edge, bool flag, int lo, int hi_, int hi) {
    if (edge) { const bool on = hi_ >= lo; const int lo2 = on ? lo : 64, R = on ? hi_ - lo : 0, kb0 = 4 * hi - lo2; const float ninf = -INFINITY; int c0t;
#pragma unroll
        for (int e = 0; e < 16; ++e) { const int c0 = (e & 3) + 8 * (e >> 2);
            asm volatile("v_add_u32 %0, %2, %3\n\tv_cmp_gt_u32 vcc, %0, %4\n\tv_cndmask_b32 %1, %1, %5, vcc" : "=&v"(c0t), "+v"(p0[e]) : "v"(kb0), "n"(c0), "v"(R), "v"(ninf) : "vcc");
            asm volatile("v_add_u32 %0, %2, %3\n\tv_cmp_gt_u32 vcc, %0, %4\n\tv_cndmask_b32 %1, %1, %5, vcc" : "=&v"(c0t), "+v"(p1[e]) : "v"(kb0), "n"(c0 + 32), "v"(R), "v"(ninf) : "vcc"); } }
    float rm = __builtin_elementwise_maximum(p0[0], p1[0]);
#pragma unroll
    for (int e = 1; e < 16; ++e) rm = __builtin_elementwise_maximum(rm, __builtin_elementwise_maximum(p0[e], p1[e]));
    rm = xhalf_max(rm);
    return flag ? rm : -INFINITY;
}
__device__ __forceinline__ void decide(f32x16& p0, f32x16& p1, float rm, SmState& S, f32x16 (&o)[2], LAS float* wsf, int r32, int hi) {
    const bool valid = rm > -INFINITY;
    const bool need = S.seen ? (rm > 8.0f) : (valid && (rm > 8.0f || rm < -8.0f));
    if (__any(need)) {
        float dl = 0.f, f = 1.f;
        if (valid) { if (!S.seen) dl = rm; else if (rm > 0.f) { dl = rm; f = fexp2(-dl); } }
        S.m += dl; S.l *= f;
#pragma unroll
        for (int e = 0; e < 16; ++e) { p0[e] -= dl; p1[e] -= dl; }
        if (hi == 0) wsf[r32] = f;
        LDS_WAIT(); asm volatile("" ::: "memory");
#pragma unroll
        for (int e = 0; e < 16; ++e) { const float fr_ = wsf[crow(e, hi)]; o[0][e] *= fr_; o[1][e] *= fr_; }
        LDS_WAIT(); asm volatile("" ::: "memory");
    }
    S.seen = S.seen || valid;
}
typedef float f32x2_t __attribute__((ext_vector_type(2))); typedef __bf16 bf16x2_t __attribute__((ext_vector_type(2)));
__device__ __forceinline__ unsigned cvtpk_s(float lo, float hi) { f32x2_t v = {lo, hi}; bf16x2_t b = __builtin_convertvector(v, bf16x2_t); return __builtin_bit_cast(unsigned, b); }
#define SBAR() __builtin_amdgcn_sched_barrier(0)
template <bool WIN>
__device__ __forceinline__ void attn_stream(LAS unsigned char* lds, const bf16* Kg, const bf16* Vg, int j0, int qt, unsigned sel_lo, unsigned sel_hi, const bf16x8 (&qf)[4], SmState& S, f32x16 (&o)[2],
                                           LAS float* wsf, int qloc, int w, int lane) {
    const int r32 = lane & 31, hi = lane >> 5, n = qt - j0 + 1;
    LAS unsigned char* ring = lds;
#define AT_FLAG(j) (WIN ? true : ((((j) < 32 ? sel_lo >> (j) : sel_hi >> ((j) - 32)) & 1u) != 0u))
#define AT_EDGE(j) (WIN ? ((j) == qt || (j) == qt - 8) : ((j) == qt))
#define AT_LO(j) ((WIN && (j) == qt - 8) ? qloc + 1 : 0)
#define AT_HI(j) (((j) == qt) ? qloc : 63)
    __syncthreads();
    kv_dma(Kg, Vg, 64 * j0, ring, w, lane);
    if (n > 1) kv_dma(Kg, Vg, 64 * (j0 + 1), ring + AT_SLOT, w, lane);
    if (n > 2) kv_dma(Kg, Vg, 64 * (j0 + 2), ring + 2 * AT_SLOT, w, lane);
    if (n > 2) asm volatile("s_waitcnt vmcnt(4)\n\ts_barrier" ::: "memory"); else if (n > 1) asm volatile("s_waitcnt vmcnt(2)\n\ts_barrier" ::: "memory"); else asm volatile("s_waitcnt vmcnt(0)\n\ts_barrier" ::: "memory");
    f32x16 s0, s1;
    qk_ring(s0, s1, ring, qf, AT_FLAG(j0) ? S.m : INFINITY, r32, hi);
    { const float rm = mask_max(s0, s1, AT_EDGE(j0), true, AT_LO(j0), AT_HI(j0), hi); decide(s0, s1, rm, S, o, wsf, r32, hi); }
    const LAS unsigned char* vb = ring + 8192 + ((lane >> 4) & 1) * 32 + (lane & 3) * 8 + (4 * hi + ((lane & 15) >> 2)) * 64;
    const int kro = r32 * 128, sw = (r32 >> 1) & 7;
#define AT_STEP(C0, C1, N0, N1, tt) do { const int t_ = (tt), j = j0 + t_; \
        if (t_ + 2 < n) asm volatile("s_waitcnt vmcnt(2) lgkmcnt(0)\n\ts_barrier" ::: "memory"); else asm volatile("s_waitcnt vmcnt(0) lgkmcnt(0)\n\ts_barrier" ::: "memory"); \
        if (t_ + 3 < n) kv_dma(Kg, Vg, 64 * (j + 3), ring + ((t_ + 3) & 3) * AT_SLOT, w, lane); \
        const LAS unsigned char* ks = ring + ((t_ + 1) & 3) * AT_SLOT + kro; \
        bf16x8 kf[8]; \
        _Pragma("unroll") for (int i = 0; i < 8; ++i) kf[i] = *(const LAS bf16x8*)(ks + (i & 1) * 4096 + (((2 * (i >> 1) + hi) ^ sw) << 4)); \
        f32x16 cin_; { const float c1_ = AT_FLAG(j + 1) ? -S.m : -INFINITY;         \
            _Pragma("unroll") for (int e = 0; e < 16; ++e) cin_[e] = c1_; } \
        float ls = 0.f; \
        SBAR(); __builtin_amdgcn_s_setprio(1); \
        _Pragma("unroll") for (int i = 0; i < 8; ++i) { \
            if (i == 0) N0 = __builtin_amdgcn_mfma_f32_32x32x16_bf16(kf[0], qf[0], cin_, 0, 0, 0); else if (i == 1) N1 = __builtin_amdgcn_mfma_f32_32x32x16_bf16(kf[1], qf[0], cin_, 0, 0, 0); \
            else if (i & 1) N1 = __builtin_amdgcn_mfma_f32_32x32x16_bf16(kf[i], qf[i >> 1], N1, 0, 0, 0); else N0 = __builtin_amdgcn_mfma_f32_32x32x16_bf16(kf[i], qf[i >> 1], N0, 0, 0, 0); \
            C0[2 * i] = fexp2(C0[2 * i]); C0[2 * i + 1] = fexp2(C0[2 * i + 1]); C1[2 * i] = fexp2(C1[2 * i]); C1[2 * i + 1] = fexp2(C1[2 * i + 1]); \
            ls += (C0[2 * i] + C0[2 * i + 1]) + (C1[2 * i] + C1[2 * i + 1]); \
            SBAR(); } \
        __builtin_amdgcn_s_setprio(0); \
        const LAS unsigned char* vbt = vb + (t_ & 3) * AT_SLOT; \
        s16x4 vl[8], vh[8]; \
        _Pragma("unroll") for (int i = 0; i < 8; ++i) { vl[i] = vtr(vbt + (i >> 2) * 4096 + (i & 3) * 1024); vh[i] = vtr(vbt + (i >> 2) * 4096 + (i & 3) * 1024 + 512); } \
        SBAR(); \
        S.l += ls; \
        bf16x8 pa[4]; \
        _Pragma("unroll") for (int ks2 = 0; ks2 < 4; ++ks2) { const f32x16& p = (ks2 >> 1) ? C1 : C0; const int b8 = 8 * (ks2 & 1); \
            v4u wv; wv.x = cvtpk_s(p[b8], p[b8 + 1]); wv.y = cvtpk_s(p[b8 + 2], p[b8 + 3]); wv.z = cvtpk_s(p[b8 + 4], p[b8 + 5]); wv.w = cvtpk_s(p[b8 + 6], p[b8 + 7]); \
            pa[ks2] = __builtin_bit_cast(bf16x8, wv); } \
        SBAR(); __builtin_amdgcn_s_setprio(1); \
        _Pragma("unroll") for (int ks2 = 0; ks2 < 4; ++ks2) \
            _Pragma("unroll") for (int d0 = 0; d0 < 2; ++d0) { const int i = d0 * 4 + ks2; \
                const bf16x8 vf = (bf16x8){vl[i][0], vl[i][1], vl[i][2], vl[i][3], vh[i][0], vh[i][1], vh[i][2], vh[i][3]}; \
                o[d0] = __builtin_amdgcn_mfma_f32_32x32x16_bf16(pa[ks2], vf, o[d0], 0, 0, 0); } \
        __builtin_amdgcn_s_setprio(0); \
        { const int jn = j + 1; \
          const float rm = mask_max(N0, N1, AT_EDGE(jn), true, AT_LO(jn), AT_HI(jn), hi); \
          decide(N0, N1, rm, S, o, wsf, r32, hi); } \
    } while (0)
    f32x16 n0, n1;
    int t = 0;
#pragma unroll 1
    for (; t + 2 < n; t += 2) { AT_STEP(s0, s1, n0, n1, t); AT_STEP(n0, n1, s0, s1, t + 1); }
    if (t + 1 < n) { AT_STEP(s0, s1, n0, n1, t); s0 = n0; s1 = n1; }
#undef AT_STEP
    { const int t = n - 1;
      float ls = 0.f;
#pragma unroll
      for (int e = 0; e < 16; ++e) { s0[e] = fexp2(s0[e]); s1[e] = fexp2(s1[e]); ls += s0[e] + s1[e]; }
      S.l += ls;
      const LAS unsigned char* vbt = vb + (t & 3) * AT_SLOT;
#pragma unroll
      for (int ks2 = 0; ks2 < 4; ++ks2) { const f32x16& p = (ks2 >> 1) ? s1 : s0; const int b8 = 8 * (ks2 & 1);
          v4u wv; wv.x = cvtpk_s(p[b8], p[b8 + 1]); wv.y = cvtpk_s(p[b8 + 2], p[b8 + 3]); wv.z = cvtpk_s(p[b8 + 4], p[b8 + 5]); wv.w = cvtpk_s(p[b8 + 6], p[b8 + 7]);
          const bf16x8 pa = __builtin_bit_cast(bf16x8, wv);
#pragma unroll
          for (int d0 = 0; d0 < 2; ++d0) { const s16x4 vl = vtr(vbt + d0 * 4096 + ks2 * 1024), vh = vtr(vbt + d0 * 4096 + ks2 * 1024 + 512);
              const bf16x8 vf = (bf16x8){vl[0], vl[1], vl[2], vl[3], vh[0], vh[1], vh[2], vh[3]};
              o[d0] = __builtin_amdgcn_mfma_f32_32x32x16_bf16(pa, vf, o[d0], 0, 0, 0); } }
    }
    asm volatile("s_waitcnt lgkmcnt(0)" ::: "memory");
#undef AT_FLAG
#undef AT_EDGE
#undef AT_LO
#undef AT_HI
}
template <bool FIRST>
__device__ __forceinline__ void fold_branch(LAS float* outl, const f32x16 (&o)[2], float colfac, LAS float* wsf, int lane) {
    const int r32 = lane & 31, hi = lane >> 5;
    LDS_WAIT(); asm volatile("" ::: "memory");
    if (hi == 0) wsf[r32] = colfac;
    LDS_WAIT(); asm volatile("" ::: "memory");
#pragma unroll
    for (int e = 0; e < 16; ++e) { const int row = crow(e, hi); const float f = wsf[row];
#pragma unroll
        for (int d0 = 0; d0 < 2; ++d0) { LAS float* p = outl + row * 64 + d0 * 32 + r32; if (FIRST) *p = o[d0][e] * f; else *p += o[d0][e] * f; } }
    LDS_WAIT(); asm volatile("" ::: "memory");
}
__device__ __forceinline__ void attn_unit_prompt(const Args& A, LAS unsigned char* lds, int b, int g, int qt, int tid) {
    asm volatile("" : "+v"(tid));
    const int lane = tid & 63, w = tid >> 6, r32 = lane & 31, hi = lane >> 5, ql = r32 >> 2, hh = r32 & 3;
    const int qloc = 8 * w + ql, tq = 64 * qt + qloc; const size_t mrow = (size_t)b * SEQ + tq;
    unsigned char* ws = A.ws;
    LAS float* wsf = (LAS float*)(lds + AT_WSF) + w * 64; LAS float* sA = (LAS float*)(lds + AT_SA); LAS float* sB = (LAS float*)(lds + AT_SB); LAS float* sS = (LAS float*)(lds + AT_SS);
    LAS unsigned char* selb = lds + AT_SEL;
    bf16x8 qf[4];
    { const bf16* qp = (const bf16*)(ws + WS_Q) + mrow * 512 + (g * 4 + hh) * 64 + 8 * hi;
#pragma unroll
      for (int s = 0; s < 4; ++s) qf[s] = *(const GAS bf16x8*)(qp + 16 * s); }
    const float* gp = (const float*)(ws + WS_GATES) + mrow * 32 + g * 12 + hh * 3;
    const float gc = sigmoidf_(gp[0]), gs = sigmoidf_(gp[1]), gw_ = sigmoidf_(gp[2]);
    f32x16 o[2];
#pragma unroll
    for (int e = 0; e < 16; ++e) { o[0][e] = 0.f; o[1][e] = 0.f; }
    LAS float* outl = (LAS float*)(lds + AT_SA) + w * 2048;
    for (int i = tid; i < 2 * 64 * 65; i += 512) sA[i] = 0.f;
    const bf16* Kc = (const bf16*)(ws + WS_KCMP_P) + (size_t)b * 256 * 128 + g * 64; const bf16* Vc = (const bf16*)(ws + WS_VCMP_P) + (size_t)b * 256 * 128 + g * 64;
    const int nct = (4 * qt + 2) / 64 + 1;
    const int nmax = (tq - 31) >> 4;
    SmState Sc{0.f, 0.f, false};
    __syncthreads();
#pragma unroll 1
    for (int ct = 0; ct < nct; ++ct) kv_dma<128>(Kc, Vc, 64 * ct, lds + ct * AT_SLOT, w, lane);
    asm volatile("s_waitcnt vmcnt(0)\n\ts_barrier" ::: "memory");
#pragma unroll 1
    for (int pass = 0; pass < 2; ++pass) {
        float invl = 0.f;
        if (pass == 1) { const float lt = xhalf_sum(Sc.l); invl = lt > 0.f ? 1.0f / lt : 0.f; }
#pragma unroll 1
        for (int ct = 0; ct < nct; ++ct) {
            const LAS unsigned char* buf = lds + ct * AT_SLOT;
            const int hiK = nmax - 64 * ct; const bool full = __all(hiK >= 63);
            if (pass == 0) attn_tile<0>(buf, qf, Sc, o, 0, hiK, full, 0.f, wsf, sA, sB, 0, qloc, lane);
            else attn_tile<1>(buf, qf, Sc, o, 0, hiK, full, invl, wsf, sA, sB, 16 * ct, qloc, lane);
        }
    }
    __syncthreads();
    { const int q = tid >> 3, jj = tid & 7; unsigned key[8]; LAS unsigned* sK = (LAS unsigned*)sS;
#pragma unroll
      for (int e = 0; e < 8; ++e) { const int j = 8 * jj + e; const bool valid = j <= qt, forced = valid && (j == 0 || j == qt || j == qt - 1);
          const float scv = forced ? 1e9f : (valid ? sA[q * 65 + j] + sB[q * 65 + j] : -1e9f);
          unsigned uk = __float_as_uint(scv); uk ^= (uk >> 31) ? 0xFFFFFFFFu : 0x80000000u; key[e] = (uk & ~63u) | (unsigned)(63 - j); sK[q * 64 + j] = key[e]; }
      __syncthreads();
      unsigned rank[8];
#pragma unroll
      for (int e = 0; e < 8; ++e) rank[e] = 0u;
      const int nj4 = (qt < 16) ? 0 : (qt + 4) >> 2;
#pragma unroll 2
      for (int j4 = 0; j4 < nj4; ++j4) { const v4u k4 = *(const LAS v4u*)(sK + q * 64 + 4 * j4);
#pragma unroll
          for (int e = 0; e < 8; ++e) rank[e] += (k4.x > key[e] ? 1u : 0u) + (k4.y > key[e] ? 1u : 0u) + (k4.z > key[e] ? 1u : 0u) + (k4.w > key[e] ? 1u : 0u); }
      unsigned bits = 0u;
#pragma unroll
      for (int e = 0; e < 8; ++e) bits |= (rank[e] < 16u ? 1u : 0u) << e;
      selb[q * 8 + jj] = (unsigned char)bits; }
    __syncthreads();
    const unsigned sel_lo = *(const LAS unsigned*)(selb + qloc * 8), sel_hi = *(const LAS unsigned*)(selb + qloc * 8 + 4);
    __syncthreads();
    fold_branch<true>(outl, o, gc, wsf, lane);
    {
        const bf16* Kg = (const bf16*)(ws + WS_KS) + (size_t)b * SEQ * 256 + g * 64; const bf16* Vg = Kg + 128;
#pragma unroll
        for (int e = 0; e < 16; ++e) { o[0][e] = 0.f; o[1][e] = 0.f; }
        SmState S{0.f, 0.f, false};
        attn_stream<false>(lds, Kg, Vg, 0, qt, sel_lo, sel_hi, qf, S, o, wsf, qloc, w, lane);
        const float lt = xhalf_sum(S.l);
        fold_branch<false>(outl, o, lt > 0.f ? gs / lt : 0.f, wsf, lane);
    }
    {
        const bf16* Kg = (const bf16*)(ws + WS_KW) + (size_t)b * SEQ * 256 + g * 64; const bf16* Vg = Kg + 128;
#pragma unroll
        for (int e = 0; e < 16; ++e) { o[0][e] = 0.f; o[1][e] = 0.f; }
        SmState S{0.f, 0.f, false};
        attn_stream<true>(lds, Kg, Vg, qt >= 8 ? qt - 8 : 0, qt, 0u, 0u, qf, S, o, wsf, qloc, w, lane);
        const float lt = xhalf_sum(S.l);
        fold_branch<false>(outl, o, lt > 0.f ? gw_ / lt : 0.f, wsf, lane);
    }
    { bf16* mix = (bf16*)(ws + WS_MIX);
#pragma unroll
      for (int i = 0; i < 4; ++i) { const int row = i * 8 + (lane >> 3), ch = lane & 7; const f32x4 v0 = *(const LAS f32x4*)(outl + row * 64 + ch * 8), v1 = *(const LAS f32x4*)(outl + row * 64 + ch * 8 + 4);
          const int q2 = row >> 2, h2 = row & 3;
          *(GAS v4u*)(mix + ((size_t)b * SEQ + 64 * qt + 8 * w + q2) * DM + (g * 4 + h2) * 64 + ch * 8) = pack8(v0, v1); }
      LDS_WAIT(); asm volatile("" ::: "memory"); }
    __syncthreads();
}

constexpr int SA_Q = 0, SA_SC = 1024  , SA_PTR = SA_SC + 1024 * 16  , SA_RED = SA_PTR + 1024 * 8, SA_SS = SA_RED + 512, SA_LIST = SA_SS + 264 * 4,
              SA_OACC = SA_LIST + 64  , SA_OUT = SA_OACC + 8 * 256 * 4, SA_END = SA_OUT + 256 * 4;
static_assert(SA_END <= RING_BYTES, "sample attention LDS");
__device__ __forceinline__ void block_max4(float (&v)[4], LAS float* red, int tid) {
#pragma unroll
    for (int h = 0; h < 4; ++h) v[h] = wave_max(v[h]);
    __syncthreads();
    if ((tid & 63) == 0) {
#pragma unroll
        for (int h = 0; h < 4; ++h) red[(tid >> 6) * 4 + h] = v[h]; }
    __syncthreads();
#pragma unroll
    for (int h = 0; h < 4; ++h) { float m = red[h];
#pragma unroll
        for (int w = 1; w < 8; ++w) m = fmaxf(m, red[w * 4 + h]);
        v[h] = m; }
}
__device__ __forceinline__ void block_sum4(float (&v)[4], LAS float* red, int tid) {
#pragma unroll
    for (int h = 0; h < 4; ++h) v[h] = wave_sum(v[h]);
    __syncthreads();
    if ((tid & 63) == 0) {
#pragma unroll
        for (int h = 0; h < 4; ++h) red[(tid >> 6) * 4 + h] = v[h]; }
    __syncthreads();
#pragma unroll
    for (int h = 0; h < 4; ++h) { float m = red[h];
#pragma unroll
        for (int w = 1; w < 8; ++w) m += red[w * 4 + h];
        v[h] = m; }
}
template <class KRow>
__device__ __forceinline__ void sample_branch(LAS unsigned char* lds, int nkeys, const KRow& krow, long voff, const float (&gate)[4], int tid) {
    LAS float* qs = (LAS float*)(lds + SA_Q); LAS f32x4* sc = (LAS f32x4*)(lds + SA_SC); LAS float* red = (LAS float*)(lds + SA_RED);
    typedef const float* cfptr; LAS cfptr* kp = (LAS cfptr*)(lds + SA_PTR); LAS float* oacc = (LAS float*)(lds + SA_OACC); LAS float* OUT = (LAS float*)(lds + SA_OUT);
    float mx[4] = {-INFINITY, -INFINITY, -INFINITY, -INFINITY};
    for (int i = tid; i < 1024; i += 512) {
        float s[4] = {-INFINITY, -INFINITY, -INFINITY, -INFINITY};
        const float* kr = (i < nkeys) ? krow(i) : nullptr;
        kp[i] = kr;
        if (kr) { s[0] = s[1] = s[2] = s[3] = 0.f;
#pragma unroll
            for (int d4 = 0; d4 < 16; ++d4) { const f32x4 kv = *(const GAS f32x4*)(kr + 4 * d4);
#pragma unroll
                for (int h = 0; h < 4; ++h) { const f32x4 q = *(const LAS f32x4*)(qs + h * 64 + 4 * d4); s[h] += (kv[0] * q[0] + kv[1] * q[1]) + (kv[2] * q[2] + kv[3] * q[3]); } } }
        sc[i] = (f32x4){s[0], s[1], s[2], s[3]};
#pragma unroll
        for (int h = 0; h < 4; ++h) mx[h] = fmaxf(mx[h], s[h]);
    }
    block_max4(mx, red, tid);
    float sm[4] = {0.f, 0.f, 0.f, 0.f};
    for (int i = tid; i < 1024; i += 512) { f32x4 v = sc[i];
#pragma unroll
        for (int h = 0; h < 4; ++h) { const float e = (v[h] > -INFINITY && mx[h] > -INFINITY) ? fexp2(v[h] - mx[h]) : 0.f; v[h] = e; sm[h] += e; }
        sc[i] = v; }
    block_sum4(sm, red, tid);
    { f32x4 inv;
#pragma unroll
      for (int h = 0; h < 4; ++h) inv[h] = sm[h] > 0.f ? 1.0f / sm[h] : 0.f;
      for (int i = tid; i < 1024; i += 512) sc[i] = sc[i] * inv; }
    __syncthreads();
    { const int w = tid >> 6, d = tid & 63; f32x4 acc = (f32x4){0.f, 0.f, 0.f, 0.f};
      for (int i0 = w; i0 < nkeys; i0 += 128) { float vv[16]; f32x4 pp[16];
#pragma unroll
          for (int u = 0; u < 16; ++u) { const int i = i0 + 8 * u; const float* kr = (i < nkeys) ? kp[i] : nullptr; pp[u] = (i < nkeys) ? sc[i] : (f32x4){0.f, 0.f, 0.f, 0.f}; vv[u] = kr ? *(const GAS float*)(kr + voff + d) : 0.f; }
#pragma unroll
          for (int u = 0; u < 16; ++u) acc += pp[u] * vv[u]; }
#pragma unroll
      for (int h = 0; h < 4; ++h) oacc[(w * 4 + h) * 64 + d] = acc[h]; }
    __syncthreads();
    if (tid < 256) { const int hq = tid >> 6, d = tid & 63; const float gt = hq == 0 ? gate[0] : hq == 1 ? gate[1] : hq == 2 ? gate[2] : gate[3]; float s = 0.f;
#pragma unroll
        for (int w = 0; w < 8; ++w) s += oacc[(w * 4 + hq) * 64 + d];
        OUT[tid] += gt * s; }
    __syncthreads();
}
__device__ __forceinline__ void attn_unit_sample(const Args& A, LAS unsigned char* lds, int b, int g, int tid) {
    asm volatile("" : "+v"(tid));
    unsigned char* ws = A.ws;
    const float* zs = (const float*)(ws + WS_ZS) + (size_t)b * NIN;
    LAS float* qs = (LAS float*)(lds + SA_Q); LAS f32x4* sc = (LAS f32x4*)(lds + SA_SC); LAS float* ss = (LAS float*)(lds + SA_SS); LAS int* list = (LAS int*)(lds + SA_LIST); LAS float* OUT = (LAS float*)(lds + SA_OUT);
    __syncthreads();
    if (tid < 256) { qs[tid] = zs[g * 256 + tid] * QSCALE; OUT[tid] = 0.f; }
    float gate[3][4];
#pragma unroll
    for (int h = 0; h < 4; ++h)
#pragma unroll
        for (int br = 0; br < 3; ++br) gate[br][h] = sigmoidf_(zs[2304 + g * 12 + h * 3 + br]);
    __syncthreads();
    const int* pt = (const int*)A.in[7] + b * NPAGE;
    { const float* Kc = (const float*)(ws + WS_KCMP_S) + ((size_t)b * 1024 * 2 + g) * 64;
      sample_branch(lds, NBLK_S, [&](int i) { return Kc + (size_t)i * 128; }, (long)((WS_VCMP_S - WS_KCMP_S) / 4), gate[0], tid); }
    if (tid < 264) { float s = -2e9f;
        if (tid < 257) { const int j = tid; float imp[5];
#pragma unroll
            for (int e = 0; e < 5; ++e) { const int n = 4 * j - 1 + e; float v = 0.f; if (n >= 0 && n < NBLK_S) { const f32x4 p = sc[n]; v = (p[0] + p[1]) + (p[2] + p[3]); } imp[e] = v; }
            s = imp[0] + 2.0f * (imp[1] + imp[2] + imp[3]) + imp[4];
            if (j == 0 || j == 255 || j == 256) s = 1e9f; }
        ss[tid] = s; }
    __syncthreads();
    if (tid < 257) { const float s = ss[tid]; int rank = 0;
        for (int j2 = 0; j2 < 257; ++j2) { const float s2 = ss[j2]; rank += (s2 > s || (s2 == s && j2 < tid)) ? 1 : 0; }
        if (rank < 16) list[rank] = tid; }
    __syncthreads();
    { const float* cache = A.in[3]; const float* knew = zs + 768 + g * 64;
      sample_branch(lds, 1024, [&](int i) -> const float* { const int blk = list[i >> 6], pos = blk * 64 + (i & 63);
          if (pos > PAST) return (const float*)nullptr; if (pos == PAST) return knew;
          const int page = pt[pos >> 7]; return cache + (((size_t)page * PAGE + (pos & 127)) * 4 + g) * 64; }, 128L, gate[1], tid); }
    { const float* wb = A.in[4] + (size_t)b * 512 * 256; const float* knew = zs + 1024 + g * 64;
      sample_branch(lds, 512, [&](int i) -> const float* { if (i == 511) return knew; return wb + ((size_t)(i + 1) * 4 + g) * 64; }, 128L, gate[2], tid); }
    if (tid < 256) ((bf16*)(ws + WS_MIXS))[(size_t)b * DM + g * 256 + tid] = (bf16)f2bf(OUT[tid]);
    __syncthreads();
}

constexpr int N_PHASES = 12;
__global__ void __launch_bounds__(NWAVES * 64, 2) nsa_hybrid_fwd(Args args) {
    extern __shared__ __attribute__((aligned(16))) unsigned char lds_raw[];
    LAS unsigned char* lds = (LAS unsigned char*)lds_raw;
    volatile LAS unsigned* MISC = (volatile LAS unsigned*)(lds + MISC_OFF);
    const int wave_s = __builtin_amdgcn_readfirstlane(threadIdx.x >> 6);
    const int G = gridDim.x, bx = blockIdx.x, vcu = (G % 8 == 0) ? (bx % 8) * (G / 8) + bx / 8 : bx;
    gu32* ctl = (gu32*)(args.ws + WS_CTL);
    for (int u = threadIdx.x; u < (LDS_BYTES - LDSCTL_OFF) / 4; u += NWAVES * 64) ((LAS unsigned*)(lds + LDSCTL_OFF))[u] = 0u;
    __syncthreads();
    XcdBarrier bar; bar.bar = (unsigned*)(ctl + CW_BAR); bar.x = 0; bar.st = nullptr;
    if (!MK_PER_PHASE) bar = xcd_barrier_post((unsigned*)(ctl + CW_BAR), MISC + 8);
    const int lo = args.ph_lo, hi = args.ph_hi;
#ifndef PH_MASK
#define PH_MASK 0xFFF
#endif
#define IN(k) (((PH_MASK >> (k)) & 1) && lo <= (k) && (k) < hi)
#define SEAM(k) do { if (IN(k) && IN((k) + 1)) xcd_barrier(bar); if (PROBE_PHASE == (k) + 1) pt0 = rt(); if (PROBE_PHASE == (k)) pt1 = rt(); } while (0)
    unsigned long long pt0 = 0ull, pt1 = 0ull; if (PROBE_PHASE == 0) pt0 = rt();
#define RETID() do { tid = (wave_s << 6) | (int)__builtin_amdgcn_mbcnt_hi(~0u, __builtin_amdgcn_mbcnt_lo(~0u, 0u)); asm volatile("" : "+v"(tid)); } while (0)
#define PHASE_ARGS() const __attribute__((address_space(4))) Args* kp_ = (const __attribute__((address_space(4))) Args*)__builtin_amdgcn_kernarg_segment_ptr(); asm volatile("" : "+s"(kp_)); \
    const Args A = *(const Args*)kp_; unsigned char* const ws = A.ws; float* const rowss = (float*)(ws + WS_ROWSS); \
    bf16* const H0 = (bf16*)(ws + WS_H0); bf16* const XB = (bf16*)(ws + WS_XB); bf16* const XB2 = (bf16*)(ws + WS_XR); float* const XR = (float*)(ws + WS_XR); bf16* const HF = (bf16*)(ws + WS_HF); \
    float* const XRS = (float*)(ws + WS_XRS); bf16* const XBS = (bf16*)(ws + WS_XBS); bf16* const HFS = (bf16*)(ws + WS_HFS); \
    (void)rowss; (void)H0; (void)XB; (void)XB2; (void)XR; (void)HF; (void)XRS; (void)XBS; (void)HFS; \
    int tid = (wave_s << 6) | (int)__builtin_amdgcn_mbcnt_hi(~0u, __builtin_amdgcn_mbcnt_lo(~0u, 0u)); asm volatile("" : "+v"(tid)); const int lane = tid & 63, wave = wave_s; (void)lane; (void)wave;

    if (IN(0)) { PHASE_ARGS(); p0_prologue(A, lds, vcu, G, tid); }
    SEAM(0);
    if (IN(1)) { PHASE_ARGS();
        pg8::Gemm g{H0, (const bf16*)(ws + WS_WIN_T), MP, NIN, DM, DM, 0}; pg8::StaticOrder S; S.init(MP, NIN, G, bx);
        EpiInProj E{(bf16*)(ws + WS_Q), (bf16*)(ws + WS_KS), (bf16*)(ws + WS_KW), (bf16*)(ws + WS_AGLU), (float*)(ws + WS_GATES), A.out};
        pg8::gemm_phase<EpiInProj, pg8::StaticOrder, true, true>(lds, g, S, E); RETID();
        float* ZS = (float*)(ws + WS_ZS);
        skinny_gemm<1>(lds, (const bf16*)(ws + WS_HS0), DM, 0, (const bf16*)(ws + WS_WIN_T), DM, NIN / 16, bx, G, [](int task, int) { return 16 * task; },
            [&](int task, int s, int c, const float (&v)[1]) { ZS[(size_t)s * NIN + 16 * task + c] = v[0]; }, tid);
    }
    SEAM(1);
    if (IN(2)) { PHASE_ARGS();
        const int gw = vcu * NWAVES + wave, NGW = G * NWAVES;
        for (int rep = 0; rep < REP_COMPRESS; ++rep)
        { const int nfull = (586 / G) * G, nrem = 586 - nfull;
          for (int t = vcu; t < nfull; t += G) compress_wgtask(A, lds, t, wave, lane, true);
          for (int s3 = vcu; s3 < 3 * nrem; s3 += G) { const int part = s3 % 3, lo = 3 * part, hi = lo + 3; compress_wgtask(A, lds, nfull + s3 / 3, wave, lane, wave >= lo && wave < hi); } }
        __syncthreads();
        const float* ZS = (const float*)(ws + WS_ZS);
        for (size_t i0 = (size_t)vcu * 512 + tid; i0 < (size_t)SB * 512 * 64; i0 += (size_t)G * 512 * 8) {
            f32x4 v[8];
#pragma unroll
            for (int k = 0; k < 8; ++k) { const size_t i = i0 + (size_t)k * G * 512; const int s = (int)(i >> 15), r = (int)((i >> 6) & 511), c4 = (int)(i & 63);
                if (i < (size_t)SB * 512 * 64) { if (r < 511) v[k] = *(const GAS f32x4*)(A.in[4] + ((size_t)(s * 512 + r + 1) * 256 + 4 * c4)); else v[k] = *(const GAS f32x4*)(ZS + (size_t)s * NIN + 1024 + 4 * c4); } }
#pragma unroll
            for (int k = 0; k < 8; ++k) { const size_t i = i0 + (size_t)k * G * 512; const int s = (int)(i >> 15), r = (int)((i >> 6) & 511), c4 = (int)(i & 63);
                if (i < (size_t)SB * 512 * 64) *(GAS f32x4*)(A.out + O_WIN_S + ((size_t)(s * 512 + r) * 256 + 4 * c4)) = v[k]; } }
        for (int i = vcu * 512 + tid; i < SB * 256; i += G * 512) { const int s = i >> 8, c = i & 255; A.out[O_CMP_S + i] = ZS[(size_t)s * NIN + 512 + c]; A.out[O_SLC_S + i] = ZS[(size_t)s * NIN + 768 + c]; }
    }
    SEAM(2);
    if (IN(3)) { PHASE_ARGS();
        constexpr int QN = 17 + 8 + 128 + 33;
        for (int rep = 0; rep < REP_PROMPT; ++rep) {
        gu32* qctr = (gu32*)(ws + WS_CTL) + CW_Q3 + rep * 512;
        int x = (int)(xb_xcc_id() & 7u);
#pragma unroll 1
        for (;;) {
            __syncthreads();
            if (tid < 64) {
                unsigned it = 0u; if (tid == 0) it = __hip_atomic_fetch_add(qctr + 64 * x, 1u, __ATOMIC_RELAXED, __HIP_MEMORY_SCOPE_AGENT);
                it = (unsigned)__builtin_amdgcn_readfirstlane((int)it);
                int nx = x;
                if (it >= (unsigned)QN) { int t8 = tid; asm volatile("" : "+v"(t8));
                    const unsigned c = (t8 < 8) ? __hip_atomic_load(qctr + 64 * t8, __ATOMIC_RELAXED, __HIP_MEMORY_SCOPE_AGENT) : 0xffffffffu;
                    const unsigned long long open = __ballot(c < (unsigned)QN);
                    nx = open ? (int)__builtin_ctzll(open) : -1; }
                if (tid == 0) { MISC[16] = it; MISC[17] = (unsigned)nx; }
            }
            __syncthreads();
            const int it = __builtin_amdgcn_readfirstlane((int)MISC[16]), nx = __builtin_amdgcn_readfirstlane((int)MISC[17]);
            if (it >= QN) { if (nx < 0) break; x = nx; continue; }
            if (it < 17) {
#pragma unroll 1
                for (int k = 0; k < 4; ++k) { const int idx = (((x * 17 + it) << 3) + wave) * 4 + k; if (idx < 4224) ffn_weight_item(A, idx, lane); } }
            else if (it < 25) { const int idx = 8 * x + (it - 17); attn_unit_sample(A, lds, idx >> 1, idx & 1, tid); }
            else if (it < 153) { const int j = it - 25, bg = 2 * x + (j & 1); attn_unit_prompt(A, lds, bg >> 1, bg & 1, 63 - (j >> 1), tid); }
            else { const int c = it - 154;
#pragma unroll 1
                for (int k = 0; k < 4; ++k) { if (c >= 0) { if (k < 2) conv_unit_prompt(A, lds, x * 64 + 2 * c + k, tid); } else conv_unit_sample(A, lds, 4 * x + k, tid); } }
        }
        }
    }
    SEAM(3);
    if (IN(4)) { PHASE_ARGS();
        pg8::Gemm g{(const bf16*)(ws + WS_MIX), (const bf16*)(ws + WS_WOUT_T), MP, DM, DM, DM, 0}; pg8::StaticOrder S; S.init(MP, DM, G, bx);
        EpiRes<true, false> E{A.in[0], XB, nullptr, rowss + 0 * RS_STRIDE};
        pg8::gemm_phase<EpiRes<true, false>, pg8::StaticOrder, true, true>(lds, g, S, E); RETID();
        const float* xs = A.in[1]; float* rs = rowss + 0 * RS_STRIDE + MP;
        const int es_ = 16 * (tid >> 8) + (((tid >> 2) & 63) >> 4) * 4 + (tid & 3), ec_ = (tid >> 2) & 15;
        float xpre = 0.f; if (bx < DM / 16) xpre = xs[(size_t)es_ * DM + 16 * bx + ec_];
        skinny_gemm<1>(lds, (const bf16*)(ws + WS_MIXS), DM, 0, (const bf16*)(ws + WS_WOUT_T), DM, DM / 16, bx, G, [](int task, int) { return 16 * task; },
            [&](int task, int s, int c, const float (&v)[1]) { const size_t o = (size_t)s * DM + 16 * task + c; const float x1 = (task == bx ? xpre : xs[o]) + v[0]; XRS[o] = x1; XBS[o] = (bf16)f2bf(x1); skinny_rowss(x1 * x1, rs, s, tid); }, tid);
    }
    SEAM(4);
#define FFN_PHASES(L, PGU, PDN, RS_IN, RS_OUT, XBUF) \
    if (IN(PGU)) { PHASE_ARGS(); \
        pg8::Gemm g{XBUF, (const bf16*)(ws + WS_WGU_T + (L) * WGU_BYTES), MP, NGU, DM, DM, 0}; pg8::StaticOrder S; S.init(MP, NGU, G, bx); \
        EpiGateUp E{HF, rowss + (RS_IN) * RS_STRIDE}; \
        pg8::gemm_phase<EpiGateUp, pg8::StaticOrder, true, true>(lds, g, S, E); RETID(); \
        const float* rs = rowss + (RS_IN) * RS_STRIDE + MP; \
        const int es_ = 16 * (tid >> 8) + (((tid >> 2) & 63) >> 4) * 4 + (tid & 3); const float rspre = rs[es_];     \
        skinny_gemm<2>(lds, XBS, DM, 0, (const bf16*)(ws + WS_WGU_T + (L) * WGU_BYTES), DM, FF / 16, bx, G, [](int task, int j) { return 256 * ((16 * task) >> 7) + ((16 * task) & 127) + 128 * j; }, \
            [&](int task, int s, int c, const float (&v)[2]) { const float rstd = 1.0f / sqrtf(rspre * (1.0f / DM) + EPS); const float gg = v[0] * rstd, uu = v[1] * rstd; \
                HFS[(size_t)s * FF + 16 * task + c] = (bf16)f2bf(gg * sigmoidf_(gg) * uu); }, tid); \
    } \
    SEAM(PGU); \
    if (IN(PDN)) { PHASE_ARGS(); \
        pg8::Gemm g{HF, (const bf16*)(ws + WS_WD_T + (L) * WD_BYTES), MP, DM, FF, FF, 0}; pg8::StaticOrder S; S.init(MP, DM, G, bx); \
        EpiRes<false, false> E{nullptr, XBUF, nullptr, rowss + (RS_OUT) * RS_STRIDE}; \
        pg8::gemm_phase<EpiRes<false, false>, pg8::StaticOrder, true, true>(lds, g, S, E); RETID(); \
        float* rs = rowss + (RS_OUT) * RS_STRIDE + MP; \
        const int es_ = 16 * (tid >> 8) + (((tid >> 2) & 63) >> 4) * 4 + (tid & 3), ec_ = (tid >> 2) & 15; \
        float xpre = 0.f; if (bx < DM / 16) xpre = XRS[(size_t)es_ * DM + 16 * bx + ec_];                         \
        skinny_gemm<1>(lds, HFS, FF, 0, (const bf16*)(ws + WS_WD_T + (L) * WD_BYTES), FF, DM / 16, bx, G, [](int task, int) { return 16 * task; }, \
            [&](int task, int s, int c, const float (&v)[1]) { const size_t o = (size_t)s * DM + 16 * task + c; const float x2 = (task == bx ? xpre : XRS[o]) + v[0]; XRS[o] = x2; skinny_rowss(x2 * x2, rs, s, tid); }, tid); \
    } \
    SEAM(PDN);
    FFN_PHASES(0, 5, 6, 0, 1, XB)
    if (IN(8)) { PHASE_ARGS();
        gu32* const spc = (gu32*)(ws + WS_CTL) + CW_SPC;
        { const int pshift = (G >= DM / 16 + SB) ? DM / 16 : 0; int nprep = 0;
          for (int u = bx - pshift; u < SB; u += G) if (u >= 0) { pool_prep_sample(A, u, tid); ++nprep; }
          if (nprep) { __threadfence(); __syncthreads(); if (tid == 0) __hip_atomic_fetch_add(spc, (unsigned)nprep, __ATOMIC_RELEASE, __HIP_MEMORY_SCOPE_AGENT); __syncthreads(); } }
#pragma unroll 1
        for (int p = bx; p < 256; p += G) pool_fused_wg(A, lds, p & 3, p >> 2, tid);
        if (bx < DM / 16) {
            if (tid == 0) { while (__hip_atomic_load(spc, __ATOMIC_ACQUIRE, __HIP_MEMORY_SCOPE_AGENT) < (unsigned)SB) __builtin_amdgcn_s_sleep(8); }
            __syncthreads(); __threadfence(); }
        float* rs = rowss + 2 * RS_STRIDE + MP; const float* psc = A.in[24];
        const int es_ = 16 * (tid >> 8) + (((tid >> 2) & 63) >> 4) * 4 + (tid & 3), ec_ = (tid >> 2) & 15;
        float xpre = 0.f, ppre = 0.f; if (bx < DM / 16) { xpre = XRS[(size_t)es_ * DM + 16 * bx + ec_]; ppre = psc[16 * bx + ec_]; }
        skinny_gemm<1>(lds, (const bf16*)(ws + WS_ZPS), DM, 256, (const bf16*)(ws + WS_POOL_T), 256, DM / 16, bx, G, [](int task, int) { return 16 * task; },
            [&](int task, int s, int c, const float (&v)[1]) { const int col = 16 * task + c; const size_t o = (size_t)s * DM + col; const float x3 = (task == bx ? xpre + v[0] * ppre : XRS[o] + v[0] * psc[col]); XRS[o] = x3; XBS[o] = (bf16)f2bf(x3); skinny_rowss(x3 * x3, rs, s, tid); }, tid);
    }
    SEAM(8);
    FFN_PHASES(1, 9, 10, 2, 3, XB2)
    if (IN(11)) { PHASE_ARGS();
        const int gw = vcu * NWAVES + wave, NGW = G * NWAVES; const float* rs = rowss + 3 * RS_STRIDE;
        for (int m0 = 4 * gw; m0 < MP; m0 += 4 * NGW) {
            v4u xv[4][2]; float rsv[4];
#pragma unroll
            for (int q = 0; q < 4; ++q) { const GAS v4u* xr = (const GAS v4u*)(XB2 + (size_t)(m0 + q) * DM) + lane; xv[q][0] = xr[0]; xv[q][1] = xr[64]; rsv[q] = *(const GAS float*)(rs + m0 + q); }
            const GAS f32x4* gr = (const GAS f32x4*)A.in[10] + 2 * lane;
            const f32x4 g0 = gr[0], g1 = gr[1], g2 = gr[128], g3 = gr[129];
#pragma unroll
            for (int q = 0; q < 4; ++q) { const float rstd = 1.0f / sqrtf(rsv[q] * (1.0f / DM) + EPS); GAS f32x4* o = (GAS f32x4*)(A.out + O_Y + (size_t)(m0 + q) * DM) + 2 * lane;
                const v4u w0 = xv[q][0], w1 = xv[q][1];
                o[0] = (f32x4){bflo(w0.x), bfhi(w0.x), bflo(w0.y), bfhi(w0.y)} * rstd * g0; o[1] = (f32x4){bflo(w0.z), bfhi(w0.z), bflo(w0.w), bfhi(w0.w)} * rstd * g1;
                o[128] = (f32x4){bflo(w1.x), bfhi(w1.x), bflo(w1.y), bfhi(w1.y)} * rstd * g2; o[129] = (f32x4){bflo(w1.z), bfhi(w1.z), bflo(w1.w), bfhi(w1.w)} * rstd * g3; } }
        if (gw < SB) final_row(XRS + (size_t)gw * DM, rs[MP + gw], A.in[10], A.out + O_YS + (size_t)gw * DM, lane);
    }
#undef IN
#undef SEAM
}

extern "C" void kernel_launch(void* const* d_in, const int* in_sizes, int n_in, void* d_out, int out_size, void* d_ws, size_t ws_size, hipStream_t stream) {
    static int grid = 0;
    if (grid == 0) {
        if (n_in != 28 || (size_t)out_size != O_END || ws_size < WS_END) { fprintf(stderr, "kernel_launch: unexpected shapes: n_in %d out %d ws %zu\n", n_in, out_size, ws_size); grid = -1; return; }
        int dev = 0, cus = 0, per_cu = 0;
        if (hipGetDevice(&dev) != hipSuccess || hipDeviceGetAttribute(&cus, hipDeviceAttributeMultiprocessorCount, dev) != hipSuccess) { grid = -1; return; }
        if (hipFuncSetAttribute((const void*)nsa_hybrid_fwd, hipFuncAttributeMaxDynamicSharedMemorySize, LDS_BYTES) != hipSuccess) { fprintf(stderr, "kernel_launch: hipFuncSetAttribute failed\n"); grid = -1; return; }
        if (hipOccupancyMaxActiveBlocksPerMultiprocessor(&per_cu, (const void*)nsa_hybrid_fwd, NWAVES * 64, LDS_BYTES) != hipSuccess || per_cu < 1)
            fprintf(stderr, "kernel_launch: note: occupancy query reports %d workgroups per CU\n", per_cu);
        (void)hipGetLastError();
        grid = cus;
    }
    if (grid < 0) return;
    if (hipMemsetAsync((char*)d_ws + WS_CTL, 0, CTL_ZERO_BYTES, stream) != hipSuccess) { fprintf(stderr, "kernel_launch: memset failed\n"); return; }
    Args a{};
    for (int i = 0; i < 28; ++i) a.in[i] = (const float*)d_in[i];
    a.out = (float*)d_out; a.ws = (unsigned char*)d_ws;
#if MK_PER_PHASE
    for (int ph = 0; ph < N_PHASES; ++ph) { a.ph_lo = ph; a.ph_hi = ph + 1; for (int rep = 0; rep < ((ph == PROBE_REPEAT) ? 1 + PROBE_NREP : 1); ++rep) hipLaunchKernelGGL(nsa_hybrid_fwd, dim3(grid), dim3(NWAVES * 64), LDS_BYTES, stream, a); }
#else
    a.ph_lo = 0; a.ph_hi = N_PHASES;
    hipLaunchKernelGGL(nsa_hybrid_fwd, dim3(grid), dim3(NWAVES * 64), LDS_BYTES, stream, a);
#endif
    const hipError_t le = hipPeekAtLastError();
    if (le != hipSuccess) fprintf(stderr, "kernel_launch: launch failed: %s\n", hipGetErrorName(le));
}
```

```cpp
#include <hip/hip_runtime.h>
#include <cstdio>
#include <cstdint>
#ifndef PROBE_REPEAT
#define PROBE_REPEAT -1
#define PROBE_NREP 1
#endif
#ifndef REP_COMPRESS
#define REP_COMPRESS 1
#define REP_CONV 1
#define REP_SAMPLE 1
#define REP_PROMPT 1
#endif
#ifndef PROBE_PHASE
#define PROBE_PHASE -1
#endif
#ifndef MK_PER_PHASE
#define MK_PER_PHASE 0
#endif
namespace pg8 {
#define PG8_LAS __attribute__((address_space(3)))
typedef unsigned short bf16_t;
typedef short bf16x8 __attribute__((ext_vector_type(8)));
typedef float f32x4 __attribute__((ext_vector_type(4)));
typedef unsigned u32x4 __attribute__((ext_vector_type(4)));
constexpr int BM = 256, BK = 64, HALF = 128, HTB = HALF * BK * 2  , STAGE_BYTES = 8 * HTB, NXCD = 8, WGM = 4;

__host__ __device__ __forceinline__ int lds_byte(int r, int c) { const int st = (r >> 4) * 2 + (c >> 5), rr = r & 15, cc = c & 31, ob = rr * 64 + cc * 2; return st * 1024 + (ob ^ (((ob >> 9) & 1) << 5)); }
__host__ __device__ __forceinline__ void stage_rc(int b, int& R, int& C) { const int st = b / 1024, sb = b % 1024, swz = sb ^ (((sb >> 9) & 1) << 5); R = (st >> 1) * 16 + swz / 64; C = (st & 1) * 32 + (swz % 64) / 2; }
__host__ __device__ __forceinline__ int perm32(int rho) { const int n = rho >> 4, i = rho & 15; return 8 * (i >> 2) + 4 * n + (i & 3); }

struct Unit { int pm, pn; };
struct Gemm { const bf16_t* A; const bf16_t* Bt; int M, N, K, lda, acol; };

struct StaticOrder {
    int nM, nN, nwg, G, c;
    __host__ __device__ void init(int M, int N, int G_, int c_) { nM = M / BM; nN = N / BM; nwg = nM * nN; G = G_; c = c_; }
    __host__ __device__ bool next(int i, Unit& u) const {
        const long L = (long)i * G + c; if (L >= nwg) return false;
        int wgid = (int)L; { const int q = nwg / NXCD, r = nwg % NXCD, xcd = wgid % NXCD, off = wgid / NXCD; wgid = (xcd < r ? xcd * (q + 1) : r * (q + 1) + (xcd - r) * q) + off; }
        const int nig = WGM * nN, gid = wgid / nig, fm = gid * WGM, gsz = (nM - fm) < WGM ? (nM - fm) : WGM;
        u.pm = fm + ((wgid % nig) % gsz); u.pn = (wgid % nig) / gsz; return true;
    }
    __device__ __forceinline__ void a_ready(const Unit&) const {}
    __device__ __forceinline__ void done(const Unit&) const {}
};
__device__ __forceinline__ unsigned cvt_pk_bf16(float lo, float hi) { unsigned r; asm volatile("v_cvt_pk_bf16_f32 %0, %1, %2" : "=v"(r) : "v"(lo), "v"(hi)); return r; }
template <class Epi, class Sched, bool ALIGN_EPI = false, bool SP2 = false>
__device__ __forceinline__ void gemm_phase(PG8_LAS unsigned char* lds, const Gemm g, const Sched& S, const Epi& E) {
    const int tid = threadIdx.x, wid = __builtin_amdgcn_readfirstlane(tid >> 6), lane = tid & 63, wr = wid >> 2, wc = wid & 3, fr = lane & 15, fq = lane >> 4;
    const int K = g.K, nt = K / BK, lda = g.lda;
    unsigned voffA[2], voffB[2];
#pragma unroll
    for (int i = 0; i < 2; ++i) { int R, C; stage_rc(tid * 16 + i * 8192, R, C); const int Rb = Epi::PERM ? ((R & ~31) + perm32(R & 31)) : R;
        voffA[i] = (unsigned)(R * lda + C) * 2u; voffB[i] = (unsigned)(Rb * K + C) * 2u; }
    const size_t kstep = (size_t)(BK * 2);
    const size_t hstepA = (size_t)HALF * lda * 2, hstepB = (size_t)HALF * K * 2;
    const size_t tstepA = 2 * hstepA, tstepB = 2 * hstepB; const size_t acolb = (size_t)g.acol * 2;
    const unsigned ldsw = (unsigned)wid * 1024u;
    const int aoff = lds_byte(wr * 64 + fr, fq * 8), boff = lds_byte(wc * 32 + fr, fq * 8);
#define PG8_SA(b, h) (((b) * 2 + (h)) * HTB)
#define PG8_SB(b, h) ((4 + (b) * 2 + (h)) * HTB)
#define PG8_STAGE(bufoff, gbase, voff) do { _Pragma("unroll") for (int _i = 0; _i < 2; ++_i) \
        __builtin_amdgcn_global_load_lds((const unsigned*)((const char*)(gbase) + (voff)[_i]), (PG8_LAS unsigned*)(lds + (bufoff) + ldsw + _i * 8192), 16, 0, 0); } while (0)
#define PG8_LDA(dst, b, h) do { _Pragma("unroll") for (int m = 0; m < 4; ++m) _Pragma("unroll") for (int k = 0; k < 2; ++k) dst[m][k] = *(const PG8_LAS bf16x8*)(lds + PG8_SA(b, h) + aoff + m * 2048 + k * 1024); } while (0)
#define PG8_LDB(dst, b, h) do { _Pragma("unroll") for (int n = 0; n < 2; ++n) _Pragma("unroll") for (int k = 0; k < 2; ++k) dst[n][k] = *(const PG8_LAS bf16x8*)(lds + PG8_SB(b, h) + boff + n * 2048 + k * 1024); } while (0)
#define PG8_MMA(ai, bj, At, Bt) do { __builtin_amdgcn_s_setprio(1); _Pragma("unroll") for (int m = 0; m < 4; ++m) _Pragma("unroll") for (int n = 0; n < 2; ++n) _Pragma("unroll") for (int k = 0; k < 2; ++k) \
        acc[ai][bj][m][n] = __builtin_amdgcn_mfma_f32_16x16x32_bf16(Bt[n][k], At[m][k], acc[ai][bj][m][n], 0, 0, 0); __builtin_amdgcn_s_setprio(0); } while (0)
#define PG8_WAIT_V(n) asm volatile("s_waitcnt vmcnt(" #n ")" ::: "memory")
#define PG8_WAIT_L(n) asm volatile("s_waitcnt lgkmcnt(" #n ")" ::: "memory")
#define PG8_BAR __builtin_amdgcn_s_barrier()
#define PG8_SCHED __builtin_amdgcn_sched_barrier(0)
    Unit cur, nxt; int ui = 0;
    if (!S.next(0, cur)) return;
    f32x4 acc[2][2][4][2];
#pragma unroll
    for (int a = 0; a < 2; ++a)
#pragma unroll
        for (int b = 0; b < 2; ++b)
#pragma unroll
            for (int m = 0; m < 4; ++m)
#pragma unroll
                for (int n = 0; n < 2; ++n) acc[a][b][m][n] = (f32x4){0.f, 0.f, 0.f, 0.f};
    bf16x8 At[4][2], B0[2][2], B1[2][2];
    const char* cA = (const char*)g.A + (size_t)cur.pm * tstepA + (size_t)cur.pn * acolb; const char* cB = (const char*)g.Bt + (size_t)cur.pn * tstepB;
    S.a_ready(cur);
    if constexpr (SP2) {
        PG8_STAGE(PG8_SB(0, 0), cB, voffB); PG8_STAGE(PG8_SB(0, 1), cB + hstepB, voffB); PG8_STAGE(PG8_SA(0, 0), cA, voffA); PG8_STAGE(PG8_SA(0, 1), cA + hstepA, voffA);
        if (wr == 1) PG8_BAR;
        PG8_WAIT_V(2); PG8_BAR;
        PG8_STAGE(PG8_SB(1, 0), cB + kstep, voffB); PG8_STAGE(PG8_SA(1, 0), cA + kstep, voffA); PG8_STAGE(PG8_SB(1, 1), cB + hstepB + kstep, voffB);
        PG8_WAIT_V(6); PG8_BAR;
    } else {
        PG8_STAGE(PG8_SB(0, 0), cB, voffB); PG8_STAGE(PG8_SA(0, 0), cA, voffA); PG8_STAGE(PG8_SB(0, 1), cB + hstepB, voffB); PG8_STAGE(PG8_SA(0, 1), cA + hstepA, voffA);
        if (wr == 1) PG8_BAR;
        PG8_WAIT_V(4); PG8_BAR;
        PG8_STAGE(PG8_SB(1, 0), cB + kstep, voffB); PG8_STAGE(PG8_SA(1, 0), cA + kstep, voffA); PG8_STAGE(PG8_SB(1, 1), cB + hstepB + kstep, voffB);
        PG8_WAIT_V(6); PG8_BAR;
    }
    for (;;) {
        const bool has_next = S.next(ui + 1, nxt);
        const char* nA = has_next ? (const char*)g.A + (size_t)nxt.pm * tstepA + (size_t)nxt.pn * acolb : cA; const char* nB = has_next ? (const char*)g.Bt + (size_t)nxt.pn * tstepB : cB;
#pragma unroll 1
        for (int t = 0; t < nt; t += 2) {
            const bool last = (t == nt - 2);
            const char* a1 = cA + (size_t)(t + 1) * kstep;
            const char* a2 = last ? nA : cA + (size_t)(t + 2) * kstep; const char* b2 = last ? nB : cB + (size_t)(t + 2) * kstep;
            const char* a3 = a2 + kstep; const char* b3 = b2 + kstep;
            if (last && has_next) S.a_ready(nxt);
            if constexpr (SP2) {
            PG8_LDB(B0, 0, 0); PG8_LDB(B1, 0, 1); PG8_SCHED; PG8_LDA(At, 0, 0); PG8_STAGE(PG8_SA(1, 1), a1 + hstepA, voffA);
            PG8_WAIT_V(8); PG8_WAIT_L(0); PG8_BAR; PG8_MMA(0, 0, At, B0); PG8_MMA(0, 1, At, B1); PG8_BAR; PG8_SCHED;
            PG8_LDA(At, 0, 1); PG8_STAGE(PG8_SB(0, 0), b2, voffB); PG8_STAGE(PG8_SB(0, 1), b2 + hstepB, voffB); PG8_STAGE(PG8_SA(0, 0), a2, voffA);
            PG8_WAIT_V(8); PG8_WAIT_L(0); PG8_BAR; PG8_MMA(1, 0, At, B0); PG8_MMA(1, 1, At, B1); PG8_BAR; PG8_SCHED;
            PG8_LDB(B0, 1, 0); PG8_LDB(B1, 1, 1); PG8_SCHED; PG8_LDA(At, 1, 0); PG8_STAGE(PG8_SA(0, 1), a2 + hstepA, voffA);
            PG8_WAIT_V(8); PG8_WAIT_L(0); PG8_BAR; PG8_MMA(0, 0, At, B0); PG8_MMA(0, 1, At, B1); PG8_BAR; PG8_SCHED;
            PG8_LDA(At, 1, 1); PG8_STAGE(PG8_SB(1, 0), b3, voffB); PG8_STAGE(PG8_SB(1, 1), b3 + hstepB, voffB); PG8_STAGE(PG8_SA(1, 0), a3, voffA);
            PG8_WAIT_V(8); PG8_WAIT_L(0); PG8_BAR; PG8_MMA(1, 0, At, B0); PG8_MMA(1, 1, At, B1); PG8_BAR; PG8_SCHED;
            } else {
            PG8_LDB(B0, 0, 0); PG8_SCHED; PG8_LDA(At, 0, 0); PG8_STAGE(PG8_SA(1, 1), a1 + hstepA, voffA);
            PG8_WAIT_L(8); PG8_BAR; PG8_WAIT_L(0); PG8_MMA(0, 0, At, B0); PG8_BAR; PG8_SCHED;
            PG8_LDB(B1, 0, 1); PG8_STAGE(PG8_SB(0, 0), b2, voffB);
            PG8_BAR; PG8_WAIT_L(0); PG8_MMA(0, 1, At, B1); PG8_BAR;
            PG8_LDA(At, 0, 1); PG8_STAGE(PG8_SA(0, 0), a2, voffA);
            PG8_BAR; PG8_WAIT_L(0); PG8_MMA(1, 0, At, B0); PG8_BAR; PG8_SCHED;
            PG8_STAGE(PG8_SB(0, 1), b2 + hstepB, voffB);
            PG8_WAIT_V(6); PG8_BAR; PG8_MMA(1, 1, At, B1); PG8_BAR;
            PG8_LDB(B0, 1, 0); PG8_SCHED; PG8_LDA(At, 1, 0); PG8_STAGE(PG8_SA(0, 1), a2 + hstepA, voffA);
            PG8_WAIT_L(8); PG8_BAR; PG8_WAIT_L(0); PG8_MMA(0, 0, At, B0); PG8_BAR; PG8_SCHED;
            PG8_LDB(B1, 1, 1); PG8_STAGE(PG8_SB(1, 0), b3, voffB);
            PG8_BAR; PG8_WAIT_L(0); PG8_MMA(0, 1, At, B1); PG8_BAR;
            PG8_LDA(At, 1, 1); PG8_STAGE(PG8_SA(1, 0), a3, voffA);
            PG8_BAR; PG8_WAIT_L(0); PG8_MMA(1, 0, At, B0); PG8_BAR; PG8_SCHED;
            PG8_STAGE(PG8_SB(1, 1), b3 + hstepB, voffB);
            PG8_WAIT_V(6); PG8_BAR; PG8_MMA(1, 1, At, B1); PG8_BAR;
            }
        }
        if constexpr (ALIGN_EPI) { if (wr == 0) PG8_BAR; }
        if constexpr (!Epi::AFTER_DRAIN) { E(acc, cur, wr, wc, fr, fq); S.done(cur); }
        if (!has_next) break;
#pragma unroll
        for (int a = 0; a < 2; ++a)
#pragma unroll
            for (int b = 0; b < 2; ++b)
#pragma unroll
                for (int m = 0; m < 4; ++m)
#pragma unroll
                    for (int n = 0; n < 2; ++n) acc[a][b][m][n] = (f32x4){0.f, 0.f, 0.f, 0.f};
        cur = nxt; cA = nA; cB = nB; ++ui;
        if constexpr (ALIGN_EPI) { if (wr == 1) PG8_BAR; }
    }
    PG8_WAIT_V(0);
    if constexpr (!ALIGN_EPI) { if (wr == 0) PG8_BAR; }
    PG8_BAR;
    if constexpr (Epi::AFTER_DRAIN) { E.fused(acc, cur, wr, wc, fr, fq, lds, wid, lane); S.done(cur); }
#undef PG8_SA
#undef PG8_SB
#undef PG8_STAGE
#undef PG8_LDA
#undef PG8_LDB
#undef PG8_MMA
#undef PG8_WAIT_V
#undef PG8_WAIT_L
#undef PG8_BAR
#undef PG8_SCHED
}
}

constexpr int NWAVES = 8;
constexpr int DM = 1024, SEQ = 4096, NB = 8, MP = NB * SEQ;
constexpr int SB = 32, PAST = 16384, NPAGE = 128, PAGE = 128;
constexpr int IN_A = 2328, NIN = 2560, FF = 2816, NGU = 2 * FF;
constexpr int CONVW = 31, CCH = 512, POOLB = 15;
constexpr float EPS = 1e-6f;
constexpr float LOG2E = 1.4426950408889634f;
constexpr float QSCALE = 0.125f * LOG2E;
constexpr int NCH_S = 1024, NBLK_S = 1023, NCH_P = 256, NBLK_P = 255;
constexpr size_t O_Y = 0, O_YS = 33554432, O_CMP_P = 33587200, O_CMP_S = 41975808, O_SLC_P = 41984000, O_SLC_S = 50372608,
                 O_WIN_P = 50380800, O_WIN_S = 51429376, O_CONV_P = 55623680, O_CONV_S = 55746560, O_POOL_P = 56238080, O_POOL_S = 56360960, O_END = 56852480;
constexpr size_t MiB = 1u << 20;
constexpr size_t WS_CTL = 0, CTL_ZERO_BYTES = 2 * MiB;
constexpr size_t WS_ROWSS = 1 * MiB;
constexpr int RS_STRIDE = MP + SB;
constexpr size_t WS_POSTQ = 1 * MiB + 768 * 1024;
constexpr size_t WS_WIN_T = 4 * MiB, WS_WOUT_T = 10 * MiB, WS_WGU_T = 12 * MiB, WS_WD_T = 34 * MiB, WS_POOL_T = 46 * MiB, WS_W1F = 47 * MiB, WS_W2T = 48 * MiB;
constexpr size_t WGU_BYTES = (size_t)NGU * DM * 2, WD_BYTES = (size_t)DM * FF * 2;
constexpr size_t WS_HS0 = 49 * MiB, WS_ZS = WS_HS0 + 65536, WS_MIXS = WS_ZS + 327680, WS_XRS = WS_MIXS + 65536, WS_XBS = WS_XRS + 131072, WS_HFS = WS_XBS + 65536, WS_ZPS = WS_HFS + 180224;
constexpr size_t WS_KCMP_P = 52 * MiB, WS_VCMP_P = 53 * MiB, WS_KCMP_S = 54 * MiB, WS_VCMP_S = 70 * MiB;
constexpr size_t WS_H0 = 96 * MiB, WS_Q = 160 * MiB, WS_KS = 192 * MiB, WS_KW = 208 * MiB, WS_GATES = 224 * MiB, WS_AGLU = 232 * MiB, WS_MIX = 264 * MiB,
                 WS_XR = 328 * MiB, WS_XB = 456 * MiB, WS_HF = 520 * MiB, WS_Z = 696 * MiB, WS_END = 768 * MiB;
static_assert(WS_ZPS + 65536 <= WS_KCMP_P && WS_WGU_T + 2 * WGU_BYTES <= WS_WD_T && WS_WD_T + 2 * WD_BYTES <= WS_POOL_T, "ws map");
constexpr int CW_TMO = 0, CW_BAR = 4096, CW_Q3 = 8192;
constexpr int RING_BYTES = 147456, LDSCTL_OFF = RING_BYTES, MISC_OFF = LDSCTL_OFF + 320, LDS_BYTES = 148480;

#define GAS __attribute__((address_space(1)))
#define LAS __attribute__((address_space(3)))
typedef unsigned short bf16;
typedef unsigned v4u __attribute__((ext_vector_type(4)));
typedef float f32x4 __attribute__((ext_vector_type(4)));
typedef short bf16x8 __attribute__((ext_vector_type(8)));
typedef GAS unsigned gu32;
typedef GAS unsigned long long gu64;
#define RLX_AGENT __ATOMIC_RELAXED, __HIP_MEMORY_SCOPE_AGENT
#define LDS_WAIT() asm volatile("s_waitcnt lgkmcnt(0)" ::: "memory")
#define VM_WAIT() asm volatile("s_waitcnt vmcnt(0)" ::: "memory")
__device__ __forceinline__ unsigned long long rt() { return __builtin_amdgcn_s_memrealtime(); }
__device__ __forceinline__ unsigned f2bf(float f) { unsigned u = __builtin_bit_cast(unsigned, f); return (u + 0x7fffu + ((u >> 16) & 1u)) >> 16; }
__device__ __forceinline__ unsigned pk2(float lo, float hi) { return f2bf(lo) | (f2bf(hi) << 16); }

#define XB_TMO      128
#define XB_XCNT(j)  (256  + 64 * (j))
#define XB_XSUB(j)  (1280 + 64 * (j))
#define XB_XGEN(j)  (2304 + 64 * (j))
#define XB_TOP      3328
#define XB_TOPGEN   3392
#define XCD_BAR_WORDS 3456
#define XB_SPIN_CAP (1u << 18)

__device__ __forceinline__ unsigned xb_ld(unsigned* p)              { return __hip_atomic_load(p, __ATOMIC_RELAXED, __HIP_MEMORY_SCOPE_AGENT); }
__device__ __forceinline__ unsigned xb_add(unsigned* p, unsigned v) { return __hip_atomic_fetch_add(p, v, __ATOMIC_RELAXED, __HIP_MEMORY_SCOPE_AGENT); }
__device__ __forceinline__ unsigned xb_xcc_id() { return (unsigned)__builtin_amdgcn_s_getreg((3 << 11) | 20) & 0xFu; }
#define XB_SPIN(cond, bar) do { unsigned _sp = 0; while (cond) { __builtin_amdgcn_s_sleep(1); \
    if ((++_sp & 255u) == 0u) { if (xb_ld(&(bar)[XB_TMO])) break; if (_sp > XB_SPIN_CAP) { atomicAdd(&(bar)[XB_TMO], 1u); break; } } } } while (0)

struct XcdBarrier {
    unsigned* bar; unsigned x;
    volatile LAS unsigned* st;
};

__device__ __forceinline__ XcdBarrier xcd_barrier_post(unsigned* bar, volatile LAS unsigned* st) {
    XcdBarrier b; b.bar = bar; b.x = xb_xcc_id(); b.st = st;
    if (threadIdx.x == 0) (void)xb_add(&bar[XB_XCNT(b.x)], 1u);
    return b;
}
__device__ __forceinline__ void xcd_barrier_complete(unsigned* bar, unsigned x, unsigned& nloc, unsigned& nx) {
    const unsigned G = gridDim.x * gridDim.y * gridDim.z;
    unsigned sum, cnt, mine, sp = 0u;
    for (;;) {
        sum = 0u; cnt = 0u; mine = 0u;
#pragma unroll
        for (unsigned j = 0; j < 16; ++j) { const unsigned c = xb_ld(&bar[XB_XCNT(j)]); sum += c; cnt += (c > 0u) ? 1u : 0u; mine = (j == x) ? c : mine; }
        if (sum == G) break;
        __builtin_amdgcn_s_sleep(1);
        if ((++sp & 255u) == 0u) { if (xb_ld(&bar[XB_TMO])) break; if (sp > XB_SPIN_CAP) { atomicAdd(&bar[XB_TMO], 1u); break; } }
    }
    nloc = mine > 0u ? mine : 1u; nx = cnt > 0u ? cnt : 1u;
}

__device__ __forceinline__ void xcd_barrier(const XcdBarrier& b) {
    asm volatile("s_waitcnt vmcnt(0)" ::: "memory");
    __syncthreads();
    if (threadIdx.x == 0) {
        unsigned* bar = b.bar;
        __builtin_amdgcn_s_waitcnt(0);
        unsigned nloc = b.st[0], nx = b.st[1];
        if (nloc == 0u) { xcd_barrier_complete(bar, b.x, nloc, nx); b.st[0] = nloc; b.st[1] = nx; }
        const unsigned old = xb_add(&bar[XB_XSUB(b.x)], 1u);
        const unsigned gen = old / nloc;
        if (old + 1u == (gen + 1u) * nloc) {
            __builtin_amdgcn_fence(__ATOMIC_RELEASE, "agent");
            asm volatile("s_waitcnt vmcnt(0)" ::: "memory");
            const unsigned og = xb_add(&bar[XB_TOP], 1u);
            const unsigned tg = og / nx;
            if (og + 1u == (tg + 1u) * nx) xb_add(&bar[XB_TOPGEN], 1u);
            else XB_SPIN(xb_ld(&bar[XB_TOPGEN]) == tg, bar);
            __builtin_amdgcn_fence(__ATOMIC_ACQUIRE, "agent");
            xb_add(&bar[XB_XGEN(b.x)], 1u);
            asm volatile("s_waitcnt vmcnt(0)" ::: "memory");
        } else {
            XB_SPIN(xb_ld(&bar[XB_XGEN(b.x)]) == gen, bar);
            __builtin_amdgcn_fence(__ATOMIC_ACQUIRE, "agent");
            asm volatile("s_waitcnt vmcnt(0)" ::: "memory");
        }
    }
    __syncthreads();
}

typedef float f32x16 __attribute__((ext_vector_type(16)));
typedef float f32x2 __attribute__((ext_vector_type(2)));
typedef short s16x4 __attribute__((ext_vector_type(4)));
typedef unsigned u32x2 __attribute__((ext_vector_type(2)));
__device__ __forceinline__ float bf2f(unsigned short u) { return __builtin_bit_cast(float, (unsigned)u << 16); }
__device__ __forceinline__ float bflo(unsigned w) { return __builtin_bit_cast(float, w << 16); }
__device__ __forceinline__ float bfhi(unsigned w) { return __builtin_bit_cast(float, w & 0xffff0000u); }
__device__ __forceinline__ float fexp2(float x) { return __builtin_amdgcn_exp2f(x); }
__device__ __forceinline__ float frcp(float x) { return __builtin_amdgcn_rcpf(x); }
__device__ __forceinline__ float sigmoidf_(float x) { return frcp(1.0f + fexp2(-x * LOG2E)); }
__device__ __forceinline__ float wave_sum(float v) {
#pragma unroll
    for (int o = 1; o < 64; o <<= 1) v += __shfl_xor(v, o);
    return v;
}
__device__ __forceinline__ float wave_max(float v) {
#pragma unroll
    for (int o = 1; o < 64; o <<= 1) v = fmaxf(v, __shfl_xor(v, o));
    return v;
}
__device__ __forceinline__ void atomic_addf(float* p, float v) { __hip_atomic_fetch_add(p, v, __ATOMIC_RELAXED, __HIP_MEMORY_SCOPE_AGENT); }
__device__ __forceinline__ v4u pack8(const f32x4 a, const f32x4 b) { v4u w; w.x = pg8::cvt_pk_bf16(a[0], a[1]); w.y = pg8::cvt_pk_bf16(a[2], a[3]); w.z = pg8::cvt_pk_bf16(b[0], b[1]); w.w = pg8::cvt_pk_bf16(b[2], b[3]); return w; }

struct Args { const float* in[28]; float* out; unsigned char* ws; int ph_lo, ph_hi; };
struct Frame {
    LAS unsigned char* lds; volatile LAS unsigned* MISC; gu32* ctl;
    int tid, lane, wave, vcu, G;
    const float* const* in; float* out; unsigned char* ws;
};

using pg8::Unit;
struct EpiInProj {
    static constexpr bool PERM = true, AFTER_DRAIN = false;
    bf16* Q; bf16* KS; bf16* KW; bf16* AGLU; float* GATES; float* out;
    __device__ __forceinline__ void operator()(const f32x4 (&acc)[2][2][4][2], const Unit& u, int wr, int wc, int fr, int fq) const {
        const int row0 = u.pm * 256 + wr * 64 + fr, cw = wc * 32 + 8 * fq, pn = u.pn;
        if (pn < 2) {
#pragma unroll
            for (int ai = 0; ai < 2; ++ai)
#pragma unroll
                for (int m = 0; m < 4; ++m) { const int row = row0 + ai * 128 + m * 16;
#pragma unroll
                    for (int bj = 0; bj < 2; ++bj) *(GAS v4u*)(Q + (size_t)row * 512 + pn * 256 + bj * 128 + cw) = pack8(acc[ai][bj][m][0] * QSCALE, acc[ai][bj][m][1] * QSCALE); }
        } else if (pn == 2 || pn == 3) {
            float* o = out + (pn == 2 ? O_CMP_P : O_SLC_P);
#pragma unroll
            for (int ai = 0; ai < 2; ++ai)
#pragma unroll
                for (int m = 0; m < 4; ++m) { const int row = row0 + ai * 128 + m * 16;
#pragma unroll
                    for (int bj = 0; bj < 2; ++bj) { const size_t off = (size_t)row * 256 + bj * 128 + cw;
                        *(GAS f32x4*)(o + off) = acc[ai][bj][m][0]; *(GAS f32x4*)(o + off + 4) = acc[ai][bj][m][1];
                        if (pn == 3) *(GAS v4u*)(KS + off) = pack8(acc[ai][bj][m][0], acc[ai][bj][m][1]); } }
        } else if (pn == 4) {
#pragma unroll
            for (int ai = 0; ai < 2; ++ai)
#pragma unroll
                for (int m = 0; m < 4; ++m) { const int row = row0 + ai * 128 + m * 16; const int t = row & (SEQ - 1), b = row >> 12;
#pragma unroll
                    for (int bj = 0; bj < 2; ++bj) { const size_t off = (size_t)row * 256 + bj * 128 + cw;
                        *(GAS v4u*)(KW + off) = pack8(acc[ai][bj][m][0], acc[ai][bj][m][1]);
                        if (t >= SEQ - 512) { float* o = out + O_WIN_P + ((size_t)(b * 512 + t - (SEQ - 512)) * 256 + bj * 128 + cw);
                            *(GAS f32x4*)(o) = acc[ai][bj][m][0]; *(GAS f32x4*)(o + 4) = acc[ai][bj][m][1]; } } }
        } else if (pn < 9) {
            const int j = pn - 5;
#pragma unroll
            for (int ai = 0; ai < 2; ++ai)
#pragma unroll
                for (int m = 0; m < 4; ++m) { const int row = row0 + ai * 128 + m * 16; const int t = row & (SEQ - 1), b = row >> 12;
                    f32x4 a0, a1;
#pragma unroll
                    for (int e = 0; e < 4; ++e) { a0[e] = acc[ai][0][m][0][e] * sigmoidf_(acc[ai][1][m][0][e]); a1[e] = acc[ai][0][m][1][e] * sigmoidf_(acc[ai][1][m][1][e]); }
                    const int col = j * 128 + cw;
                    *(GAS v4u*)(AGLU + (size_t)row * 512 + col) = pack8(a0, a1);
                    if (t >= SEQ - (CONVW - 1)) { float* o = out + O_CONV_P + ((size_t)(b * (CONVW - 1) + t - (SEQ - (CONVW - 1))) * CCH + col);
                        *(GAS f32x4*)(o) = a0; *(GAS f32x4*)(o + 4) = a1; } }
        } else {
            if (wc == 0) {
#pragma unroll
                for (int ai = 0; ai < 2; ++ai)
#pragma unroll
                    for (int m = 0; m < 4; ++m) { const int row = row0 + ai * 128 + m * 16; float* o = GATES + (size_t)row * 32 + 8 * fq;
                        *(GAS f32x4*)(o) = acc[ai][0][m][0]; *(GAS f32x4*)(o + 4) = acc[ai][0][m][1]; }
            }
        }
    }
};
template <bool FROM_X, bool SCALE> struct EpiRes {
    static constexpr bool PERM = true, AFTER_DRAIN = false;
    const float* xin; bf16* XB; const float* scale; float* rowss;
    __device__ __forceinline__ void operator()(const f32x4 (&acc)[2][2][4][2], const Unit& u, int wr, int wc, int fr, int fq) const {
        const int row0 = u.pm * 256 + wr * 64 + fr, col0 = u.pn * 256 + wc * 32 + 8 * fq;
        f32x4 s0[2], s1[2];
        if (SCALE) {
#pragma unroll
            for (int bj = 0; bj < 2; ++bj) { s0[bj] = *(const GAS f32x4*)(scale + col0 + bj * 128); s1[bj] = *(const GAS f32x4*)(scale + col0 + bj * 128 + 4); } }
#pragma unroll
        for (int ai = 0; ai < 2; ++ai) {
            f32x4 ra[4][2], rb[4][2]; v4u rw[4][2];
#pragma unroll
            for (int m = 0; m < 4; ++m)
#pragma unroll
                for (int bj = 0; bj < 2; ++bj) { const size_t off = (size_t)(row0 + ai * 128 + m * 16) * DM + col0 + bj * 128;
                    if (FROM_X) { ra[m][bj] = *(const GAS f32x4*)(xin + off); rb[m][bj] = *(const GAS f32x4*)(xin + off + 4); } else rw[m][bj] = *(const GAS v4u*)(XB + off); }
#pragma unroll
            for (int m = 0; m < 4; ++m) { const int row = row0 + ai * 128 + m * 16; float ss = 0.f;
#pragma unroll
                for (int bj = 0; bj < 2; ++bj) { const size_t off = (size_t)row * DM + col0 + bj * 128;
                    f32x4 v0, v1;
                    if (FROM_X) { v0 = ra[m][bj]; v1 = rb[m][bj]; }
                    else { const v4u w = rw[m][bj]; v0 = (f32x4){bflo(w.x), bfhi(w.x), bflo(w.y), bfhi(w.y)}; v1 = (f32x4){bflo(w.z), bfhi(w.z), bflo(w.w), bfhi(w.w)}; }
                    if (SCALE) { v0 += acc[ai][bj][m][0] * s0[bj]; v1 += acc[ai][bj][m][1] * s1[bj]; } else { v0 += acc[ai][bj][m][0]; v1 += acc[ai][bj][m][1]; }
                    *(GAS v4u*)(XB + off) = pack8(v0, v1);
                    ss += (v0[0] * v0[0] + v0[1] * v0[1]) + (v0[2] * v0[2] + v0[3] * v0[3]) + (v1[0] * v1[0] + v1[1] * v1[1]) + (v1[2] * v1[2] + v1[3] * v1[3]); }
                ss += __shfl_xor(ss, 16); ss += __shfl_xor(ss, 32);
                if (fq == 0) atomic_addf(rowss + row, ss); }
        }
    }
};
struct EpiGateUp {
    static constexpr bool PERM = true, AFTER_DRAIN = false;
    bf16* HF; const float* rowss;
    __device__ __forceinline__ void operator()(const f32x4 (&acc)[2][2][4][2], const Unit& u, int wr, int wc, int fr, int fq) const {
        const int row0 = u.pm * 256 + wr * 64 + fr, col = u.pn * 128 + wc * 32 + 8 * fq;
#pragma unroll
        for (int ai = 0; ai < 2; ++ai)
#pragma unroll
            for (int m = 0; m < 4; ++m) { const int row = row0 + ai * 128 + m * 16;
                const float rstd = __builtin_amdgcn_rsqf(*(const GAS float*)(rowss + row) * (1.0f / DM) + EPS);
                f32x4 h0, h1;
#pragma unroll
                for (int e = 0; e < 4; ++e) { const float g0 = acc[ai][0][m][0][e] * rstd, u0 = acc[ai][1][m][0][e] * rstd, g1 = acc[ai][0][m][1][e] * rstd, u1 = acc[ai][1][m][1][e] * rstd;
                    h0[e] = g0 * sigmoidf_(g0) * u0; h1[e] = g1 * sigmoidf_(g1) * u1; }
                *(GAS v4u*)(HF + (size_t)row * FF + col) = pack8(h0, h1); }
    }
};

__device__ __forceinline__ int map_in(int n) {
    if (n < 1280) return n;
    if (n < 1304) return 2304 + (n - 1280);
    const int uu = n - 1304, half = uu >> 9, c = uu & 511;
    return 1280 + (c >> 7) * 256 + half * 128 + (c & 127);
}
__device__ __forceinline__ void tr_item(const float* W, int K, int N, bf16* WT, int mode, const float* gain, int item, int lane) {
    asm volatile("" : "+v"(lane));
    const int nblk = (N + 63) / 64, kb = item / nblk, nb = item % nblk, k0 = 64 * kb, n = 64 * nb + lane;
    const bool ok = n < N; const int nn = ok ? n : N - 1;
    const float* src = W + (size_t)k0 * N + nn;
    float v[64];
#pragma unroll
    for (int i = 0; i < 64; ++i) v[i] = *(const GAS float*)(src + (size_t)i * N);
    if (gain) {
#pragma unroll
        for (int i = 0; i < 64; ++i) v[i] *= gain[k0 + i]; }
    int r = n; if (mode == 1) r = map_in(nn); else if (mode == 2) r = 256 * (nn >> 7) + (nn & 127); else if (mode == 3) r = 256 * (nn >> 7) + 128 + (nn & 127);
    if (ok) { GAS v4u* dst = (GAS v4u*)(WT + (size_t)r * K + k0);
#pragma unroll
        for (int c = 0; c < 8; ++c) { v4u o; o.x = pk2(v[8 * c], v[8 * c + 1]); o.y = pk2(v[8 * c + 2], v[8 * c + 3]); o.z = pk2(v[8 * c + 4], v[8 * c + 5]); o.w = pk2(v[8 * c + 6], v[8 * c + 7]); dst[c] = o; } }
}
template <int NR>
__device__ __forceinline__ void rms_rows_to_bf16(const float* const (&xrow)[NR], const float* gain, bf16* const (&orow)[NR], int lane) {
    const GAS f32x4* gr = (const GAS f32x4*)gain + lane;
    f32x4 v[NR][4];
#pragma unroll
    for (int q = 0; q < NR; ++q) { const GAS f32x4* xr = (const GAS f32x4*)xrow[q] + lane;
#pragma unroll
        for (int j = 0; j < 4; ++j) v[q][j] = xr[64 * j]; }
    f32x4 g[4];
#pragma unroll
    for (int j = 0; j < 4; ++j) g[j] = gr[64 * j];
#pragma unroll
    for (int q = 0; q < NR; ++q) { float s = 0.f;
#pragma unroll
        for (int j = 0; j < 4; ++j) s += (v[q][j].x * v[q][j].x + v[q][j].y * v[q][j].y) + (v[q][j].z * v[q][j].z + v[q][j].w * v[q][j].w);
        const float rstd = 1.0f / sqrtf(wave_sum(s) * (1.0f / DM) + EPS);
        GAS unsigned long long* o8 = (GAS unsigned long long*)orow[q] + lane;
#pragma unroll
        for (int j = 0; j < 4; ++j)
            o8[64 * j] = (unsigned long long)pk2(v[q][j].x * rstd * g[j].x, v[q][j].y * rstd * g[j].y) | ((unsigned long long)pk2(v[q][j].z * rstd * g[j].z, v[q][j].w * rstd * g[j].w) << 32); }
}
__device__ __forceinline__ void ffn_weight_item(const Args& A, int idx, int lane) {
    unsigned char* ws = A.ws; const int l = idx / 2112, r = idx % 2112, which = r / 704, item = r % 704;
    if (which == 0) tr_item(A.in[25] + (size_t)l * DM * FF, DM, FF, (bf16*)(ws + WS_WGU_T + l * WGU_BYTES), 2, A.in[9] + l * DM, item, lane);
    else if (which == 1) tr_item(A.in[26] + (size_t)l * DM * FF, DM, FF, (bf16*)(ws + WS_WGU_T + l * WGU_BYTES), 3, A.in[9] + l * DM, item, lane);
    else tr_item(A.in[27] + (size_t)l * FF * DM, FF, DM, (bf16*)(ws + WS_WD_T + l * WD_BYTES), 0, nullptr, item, lane);
}
__device__ __forceinline__ void p0_prologue(const Args& A, LAS unsigned char* lds, int vcu, int G, int tid) {
    const int lane = tid & 63, wave = tid >> 6;
    unsigned char* ws = A.ws;
    const int gw = vcu * NWAVES + wave, NGW = G * NWAVES;
    constexpr int I_IN = 16 * 37, I_OUT = 16 * 16, I_POOL = 4 * 4, I_W2 = 1;
    constexpr int NITEMS = I_IN + I_OUT + 4 * I_POOL + 2 * I_W2;
#pragma unroll 1
    for (int it = wave * G + vcu; it < NITEMS; it += NGW) {
        int r = it;
        if (r < I_IN) { tr_item(A.in[11], DM, IN_A, (bf16*)(ws + WS_WIN_T), 1, nullptr, r, lane); continue; } r -= I_IN;
        if (r < I_OUT) { tr_item(A.in[12], DM, DM, (bf16*)(ws + WS_WOUT_T), 0, nullptr, r, lane); continue; } r -= I_OUT;
        if (r < 4 * I_POOL) { const int g = r / I_POOL; tr_item(A.in[23] + (size_t)g * 65536, 256, 256, (bf16*)(ws + WS_POOL_T) + (size_t)g * 65536, 0, nullptr, r % I_POOL, lane); continue; } r -= 4 * I_POOL;
        if (r < I_W2) { tr_item(A.in[15], 64, 64, (bf16*)(ws + WS_W2T), 0, nullptr, r, lane); continue; } r -= I_W2;
        tr_item(A.in[18], 64, 64, (bf16*)(ws + WS_W2T) + 4096, 0, nullptr, r, lane);
    }
    { GAS v4u* z = (GAS v4u*)(ws + WS_WIN_T + (size_t)2328 * DM * 2); const int n16 = (NIN - 2328) * DM * 2 / 16;
      for (int i = gw * 64 + lane; i < n16; i += NGW * 64) z[i] = (v4u){0u, 0u, 0u, 0u}; }
    for (int idx = gw * 64 + lane; idx < 2 * 16 * 4 * 4 * 64; idx += NGW * 64) {
        const int ln = idx & 63, nbq = (idx >> 6) & 3, ds = (idx >> 8) & 3, l = (idx >> 10) & 15, kv = idx >> 14;
        const float* w1 = A.in[kv ? 17 : 14]; const int r = ln & 31, h = ln >> 5, lp = 16 * (nbq >> 1) + l, e = 32 * (nbq & 1) + r;
        float f[8];
#pragma unroll
        for (int j = 0; j < 8; ++j) f[j] = w1[((size_t)lp * 64 + 16 * ds + 8 * h + j) * 64 + e];
        v4u o; o.x = pk2(f[0], f[1]); o.y = pk2(f[2], f[3]); o.z = pk2(f[4], f[5]); o.w = pk2(f[6], f[7]);
        *((GAS v4u*)(ws + WS_W1F) + idx) = o;
    }
    if (vcu < 32) {
        LAS float* red = (LAS float*)(lds + 12288);
        const int o = tid & 127, part = tid >> 7, kv = o >> 6, e = o & 63; const float* pos = A.in[kv ? 16 : 13]; const float* w1 = A.in[kv ? 17 : 14];
        float s = 0.f; const int k0 = vcu * 64 + part * 16;
#pragma unroll
        for (int k = 0; k < 16; ++k) s += pos[k0 + k] * w1[(size_t)(k0 + k) * 64 + e];
        red[tid] = s; __syncthreads();
        if (tid < 128) { const float part = (red[tid] + red[tid + 128]) + (red[tid + 256] + red[tid + 384]);
            __hip_atomic_fetch_add((long long*)(ws + WS_POSTQ) + tid, (long long)__builtin_rintf(part * 1099511627776.0f), __ATOMIC_RELAXED, __HIP_MEMORY_SCOPE_AGENT); }
        __syncthreads();
    }
    for (int i = gw * 64 + lane; i < NB * 128 + SB * 128; i += NGW * 64) {
        if (i < NB * 128) { const int b = i >> 7, c = i & 127; ((bf16*)(ws + WS_KCMP_P))[((size_t)b * 256 + 255) * 128 + c] = 0; ((bf16*)(ws + WS_VCMP_P))[((size_t)b * 256 + 255) * 128 + c] = 0; }
        else { const int j = i - NB * 128, b = j >> 7, c = j & 127; ((float*)(ws + WS_KCMP_S))[((size_t)b * 1024 + 1023) * 128 + c] = 0.f; ((float*)(ws + WS_VCMP_S))[((size_t)b * 1024 + 1023) * 128 + c] = 0.f; }
    }
    for (int m = 8 * gw; m < MP; m += 8 * NGW) {
        const float* xr[8]; bf16* orow[8];
#pragma unroll
        for (int q = 0; q < 8; ++q) { xr[q] = A.in[0] + (size_t)(m + q) * DM; orow[q] = (bf16*)(ws + WS_H0) + (size_t)(m + q) * DM; }
        rms_rows_to_bf16<8>(xr, A.in[8], orow, lane); }
    if (gw < SB) { const float* xr[1] = {A.in[1] + (size_t)gw * DM}; bf16* orow[1] = {(bf16*)(ws + WS_HS0) + (size_t)gw * DM}; rms_rows_to_bf16<1>(xr, A.in[8], orow, lane); }
}

template <int NBK, class RowBase, class Epi>
__device__ __forceinline__ void skinny_gemm(LAS unsigned char* lds, const bf16* A0, int lda, int acol_per_task16  , const bf16* Bt, int K, int ntasks, int first, int stride, const RowBase& rowbase, const Epi& epi, int tid) {
    const int lane = tid & 63, w = tid >> 6, wu = __builtin_amdgcn_readfirstlane(tid >> 6), ks = K >> 3;
    LAS float* part = (LAS float*)lds;
    for (int task = first; task < ntasks; task += stride) {
        f32x4 acc[2][NBK];
#pragma unroll
        for (int i = 0; i < 2; ++i)
#pragma unroll
            for (int j = 0; j < NBK; ++j) acc[i][j] = (f32x4){0.f, 0.f, 0.f, 0.f};
        const bf16* A = A0 + (size_t)(task >> 4) * acol_per_task16;
        int rb[NBK];
#pragma unroll
        for (int j = 0; j < NBK; ++j) rb[j] = rowbase(task, j);
        const int kq = 8 * (lane >> 4), rl = lane & 15;
        constexpr int BQ = (NBK == 1) ? 11 : 4;
        const int kbeg = wu * ks, kend = kbeg + ks;
#pragma unroll 1
        for (int k = kbeg; k < kend; k += 32 * BQ) {
            bf16x8 a0v[BQ], a1v[BQ], bv[BQ][NBK];
#pragma unroll
            for (int q = 0; q < BQ; ++q) { const int kk = k + 32 * q;
                if (kk < kend) { a0v[q] = *(const GAS bf16x8*)(A + (size_t)rl * lda + kk + kq); a1v[q] = *(const GAS bf16x8*)(A + (size_t)(16 + rl) * lda + kk + kq);
#pragma unroll
                    for (int j = 0; j < NBK; ++j) bv[q][j] = *(const GAS bf16x8*)(Bt + (size_t)(rb[j] + rl) * K + kk + kq); } }
#pragma unroll
            for (int q = 0; q < BQ; ++q) { const int kk = k + 32 * q;
                if (kk < kend) {
#pragma unroll
                    for (int j = 0; j < NBK; ++j) { acc[0][j] = __builtin_amdgcn_mfma_f32_16x16x32_bf16(a0v[q], bv[q][j], acc[0][j], 0, 0, 0); acc[1][j] = __builtin_amdgcn_mfma_f32_16x16x32_bf16(a1v[q], bv[q][j], acc[1][j], 0, 0, 0); } } }
        }
#pragma unroll
        for (int i = 0; i < 2; ++i)
#pragma unroll
            for (int j = 0; j < NBK; ++j) *(LAS f32x4*)(part + (((w * 2 + i) * NBK + j) * 64 + lane) * 4) = acc[i][j];
        __syncthreads();
        { const int i = tid >> 8, ln = (tid >> 2) & 63, reg = tid & 3; float v[NBK];
#pragma unroll
          for (int j = 0; j < NBK; ++j) { float s = 0.f;
#pragma unroll
              for (int ww = 0; ww < 8; ++ww) s += part[(((ww * 2 + i) * NBK + j) * 64 + ln) * 4 + reg];
              v[j] = s; }
          epi(task, 16 * i + (ln >> 4) * 4 + reg, ln & 15, v); }
        __syncthreads();
    }
}
__device__ __forceinline__ void skinny_rowss(float v2, float* rowss_s, int s, int tid) {
    v2 += __shfl_xor(v2, 4); v2 += __shfl_xor(v2, 8); v2 += __shfl_xor(v2, 16); v2 += __shfl_xor(v2, 32);
    if ((tid & 60) == 0) atomic_addf(rowss_s + s, v2);
}

__device__ __forceinline__ void compress_wgtask(const Args& A, LAS unsigned char* lds, int wgtask, int wave, int lane, bool act) {
    asm volatile("" : "+v"(lane));
    LAS unsigned char* wlds = lds + wave * 8192; LAS unsigned char* bring = lds + 65536;
    const bool SAMPLE = wgtask < 552;
    int kv, local; if (SAMPLE) { kv = wgtask / 276; local = (wgtask % 276) * 8 + wave; } else { const int p = wgtask - 552; kv = p / 17; local = (p % 17) * 8 + wave; }
    const int TPS = SAMPLE ? 69 : 17, NCH = SAMPLE ? NCH_S : NCH_P, NBLK = SAMPLE ? NBLK_S : NBLK_P;
    const int tile = local % TPS, b = local / TPS;
    const int n0 = tile * 15, r = lane & 31, h = lane >> 5;
    unsigned char* ws = A.ws;
    const float* src = SAMPLE ? A.in[2] : (const float*)(A.out + O_CMP_P);
    unsigned eoff[8];
#pragma unroll
    for (int i = 0; i < 8; ++i) { const int rr = 4 * i + (lane >> 4), g = rr & 1; int n = n0 + (rr >> 1); n = n < NCH ? n : NCH - 1;
        unsigned rowbase;
        if (SAMPLE) { const int page = ((const int*)A.in[7])[b * NPAGE + (n >> 3)]; rowbase = (unsigned)(page * PAGE + (n & 7) * 16); } else rowbase = (unsigned)(b * SEQ + n * 16);
        eoff[i] = rowbase * 256u + (unsigned)((kv * 2 + g) * 64 + ((lane & 15) << 2)); }
    const GAS v4u* W1F = (const GAS v4u*)(ws + WS_W1F) + (size_t)kv * 16384 + lane;
    f32x16 acc[4];
#pragma unroll
    for (int j = 0; j < 4; ++j)
#pragma unroll
        for (int e = 0; e < 16; ++e) acc[j][e] = 0.f;
    f32x4 abuf[3][8];
#define CB_ISSUE(L, SET) do { \
        __builtin_amdgcn_global_load_lds((const unsigned*)(W1F + (size_t)((L) * 16 + 2 * wave) * 64), (LAS unsigned*)(bring + ((L) & 3) * 16384 + (2 * wave) * 1024), 16, 0, 0); \
        __builtin_amdgcn_global_load_lds((const unsigned*)(W1F + (size_t)((L) * 16 + 2 * wave + 1) * 64), (LAS unsigned*)(bring + ((L) & 3) * 16384 + (2 * wave + 1) * 1024), 16, 0, 0); \
        if (act) { _Pragma("unroll") for (int i = 0; i < 8; ++i) abuf[SET][i] = *(const GAS f32x4*)(src + (size_t)(eoff[i] + (unsigned)(L) * 256u)); } } while (0)
    asm volatile("s_waitcnt lgkmcnt(0)\n\ts_barrier" ::: "memory");
    CB_ISSUE(0, 0); CB_ISSUE(1, 1); CB_ISSUE(2, 2);
    const int wq = lane & 15, wsl = (wq >> 1), whalf = (wq & 1) * 8;
#define CB_STEP(L, SET) do { const int l_ = (L); \
        if (act) { \
        if (l_ <= 13) asm volatile("s_waitcnt vmcnt(20) lgkmcnt(0)\n\ts_barrier" ::: "memory"); \
        else if (l_ == 14) asm volatile("s_waitcnt vmcnt(10) lgkmcnt(0)\n\ts_barrier" ::: "memory"); \
        else asm volatile("s_waitcnt vmcnt(0) lgkmcnt(0)\n\ts_barrier" ::: "memory");                 \
        } else {                                                                                        \
        if (l_ <= 13) asm volatile("s_waitcnt vmcnt(4) lgkmcnt(0)\n\ts_barrier" ::: "memory"); \
        else if (l_ == 14) asm volatile("s_waitcnt vmcnt(2) lgkmcnt(0)\n\ts_barrier" ::: "memory"); \
        else asm volatile("s_waitcnt vmcnt(0) lgkmcnt(0)\n\ts_barrier" ::: "memory"); } \
        if (act) { _Pragma("unroll") for (int i = 0; i < 8; ++i) { const int rr = 4 * i + (lane >> 4); const f32x4 x = abuf[SET][i]; \
            u32x2 wv; wv.x = pg8::cvt_pk_bf16(x[0], x[1]); wv.y = pg8::cvt_pk_bf16(x[2], x[3]); \
            *(LAS u32x2*)(wlds + rr * 128 + ((wsl ^ ((rr >> 1) & 7)) << 4) + whalf) = wv; } } \
        if (l_ + 3 < 16) CB_ISSUE(l_ + 3, SET); \
        if (act) { \
        asm volatile("s_waitcnt lgkmcnt(0)" ::: "memory"); \
        const LAS unsigned char* bs = bring + (l_ & 3) * 16384; \
        _Pragma("unroll") for (int ds = 0; ds < 4; ++ds) { \
            const bf16x8 af = *(const LAS bf16x8*)(wlds + r * 128 + (((2 * ds + h) ^ ((r >> 1) & 7)) << 4)); \
            _Pragma("unroll") for (int nbq = 0; nbq < 4; ++nbq) { const v4u bfr = *(const LAS v4u*)(bs + ((ds * 4 + nbq) * 64 + lane) * 16); \
                acc[nbq] = __builtin_amdgcn_mfma_f32_32x32x16_bf16(af, __builtin_bit_cast(bf16x8, bfr), acc[nbq], 0, 0, 0); } \
            __builtin_amdgcn_sched_barrier(0); } } \
    } while (0)
#pragma unroll 1
    for (int l3 = 0; l3 < 15; l3 += 3) { CB_STEP(l3, 0); CB_STEP(l3 + 1, 1); CB_STEP(l3 + 2, 2); }
    CB_STEP(15, 0);
#undef CB_STEP
#undef CB_ISSUE
    asm volatile("s_waitcnt lgkmcnt(0)" ::: "memory");
    if (!act) return;
    LAS float* P1 = (LAS float*)wlds;
#pragma unroll
    for (int q = 0; q < 2; ++q)
#pragma unroll
        for (int reg = 0; reg < 16; ++reg) P1[((reg & 3) + 8 * (reg >> 2) + 4 * h) * 64 + 32 * q + r] = acc[2 + q][reg];
    LDS_WAIT(); asm volatile("" ::: "memory");
    const long long* post = (const long long*)(ws + WS_POSTQ) + kv * 64;
    const float pt0 = (float)post[r] * 9.094947017729282e-13f, pt1 = (float)post[32 + r] * 9.094947017729282e-13f;
#pragma unroll
    for (int q = 0; q < 2; ++q)
#pragma unroll
        for (int reg = 0; reg < 16; ++reg) { const int row = (reg & 3) + 8 * (reg >> 2) + 4 * h; const int rn = row < 30 ? row + 2 : 31;
            const float x = acc[q][reg] + P1[rn * 64 + 32 * q + r] + (q ? pt1 : pt0);
            const float t = x + 0.044715f * x * x * x;
            acc[q][reg] = x * frcp(1.0f + fexp2(-2.3022082f * t)); }
    LDS_WAIT(); asm volatile("" ::: "memory");
    LAS bf16* HB = (LAS bf16*)wlds;
#pragma unroll
    for (int q = 0; q < 2; ++q)
#pragma unroll
        for (int reg = 0; reg < 16; ++reg) HB[((reg & 3) + 8 * (reg >> 2) + 4 * h) * 72 + 32 * q + r] = (bf16)f2bf(acc[q][reg]);
    LDS_WAIT(); asm volatile("" ::: "memory");
    f32x16 o2[2];
#pragma unroll
    for (int j = 0; j < 2; ++j)
#pragma unroll
        for (int e = 0; e < 16; ++e) o2[j][e] = 0.f;
    const bf16* W2T = (const bf16*)(ws + WS_W2T) + kv * 4096;
#pragma unroll
    for (int ksq = 0; ksq < 4; ++ksq) {
        const bf16x8 a0 = *(const LAS bf16x8*)(HB + r * 72 + 16 * ksq + 8 * h);
#pragma unroll
        for (int q = 0; q < 2; ++q) { const bf16x8 bfr2 = *(const GAS bf16x8*)(W2T + (32 * q + r) * 64 + 16 * ksq + 8 * h);
            o2[q] = __builtin_amdgcn_mfma_f32_32x32x16_bf16(a0, bfr2, o2[q], 0, 0, 0); }
    }
    LDS_WAIT(); asm volatile("" ::: "memory");
#pragma unroll
    for (int q = 0; q < 2; ++q)
#pragma unroll
        for (int reg = 0; reg < 16; ++reg) { const int row = (reg & 3) + 8 * (reg >> 2) + 4 * h, n = n0 + (row >> 1), g = row & 1;
            if (row < 30 && n < NBLK) {
                if (SAMPLE) ((float*)(ws + (kv ? WS_VCMP_S : WS_KCMP_S)))[((size_t)(b * 1024 + n) * 2 + g) * 64 + 32 * q + r] = o2[q][reg];
                else ((bf16*)(ws + (kv ? WS_VCMP_P : WS_KCMP_P)))[((size_t)(b * 256 + n) * 2 + g) * 64 + 32 * q + r] = (bf16)f2bf(o2[q][reg]); } }
}

__device__ __forceinline__ void conv_ln_rows(const Args& A, LAS float* ybuf  , int nrows, bf16* mix_base  , int tid) {
    const int lane = tid & 63, w = tid >> 6;
    const float* lg = A.in[21]; const float* lb = A.in[22];
    f32x4 g0 = *(const GAS f32x4*)(lg + 8 * lane), g1 = *(const GAS f32x4*)(lg + 8 * lane + 4), b0 = *(const GAS f32x4*)(lb + 8 * lane), b1 = *(const GAS f32x4*)(lb + 8 * lane + 4);
    const int rpw = (nrows + 7) >> 3;
    if (nrows == 64) {
#pragma unroll 1
        for (int rr = 0; rr < 8; rr += 4) { const int row0 = 8 * w + rr;
            f32x4 y0[4], y1[4]; float sm[4];
#pragma unroll
            for (int q = 0; q < 4; ++q) { y0[q] = *(const LAS f32x4*)(ybuf + (row0 + q) * 512 + 8 * lane); y1[q] = *(const LAS f32x4*)(ybuf + (row0 + q) * 512 + 8 * lane + 4);
                sm[q] = (y0[q][0] + y0[q][1]) + (y0[q][2] + y0[q][3]) + (y1[q][0] + y1[q][1]) + (y1[q][2] + y1[q][3]); }
#pragma unroll
            for (int o = 1; o < 64; o <<= 1) { float t[4];
#pragma unroll
                for (int q = 0; q < 4; ++q) t[q] = __shfl_xor(sm[q], o);
#pragma unroll
                for (int q = 0; q < 4; ++q) sm[q] += t[q]; }
#pragma unroll
            for (int q = 0; q < 4; ++q) { const float mu = sm[q] * (1.0f / CCH); y0[q] -= mu; y1[q] -= mu;
                sm[q] = (y0[q][0] * y0[q][0] + y0[q][1] * y0[q][1]) + (y0[q][2] * y0[q][2] + y0[q][3] * y0[q][3]) + (y1[q][0] * y1[q][0] + y1[q][1] * y1[q][1]) + (y1[q][2] * y1[q][2] + y1[q][3] * y1[q][3]); }
#pragma unroll
            for (int o = 1; o < 64; o <<= 1) { float t[4];
#pragma unroll
                for (int q = 0; q < 4; ++q) t[q] = __shfl_xor(sm[q], o);
#pragma unroll
                for (int q = 0; q < 4; ++q) sm[q] += t[q]; }
#pragma unroll
            for (int q = 0; q < 4; ++q) { const float rstd = 1.0f / sqrtf(sm[q] * (1.0f / CCH) + EPS);
                f32x4 z0 = y0[q] * rstd * g0 + b0, z1 = y1[q] * rstd * g1 + b1;
#pragma unroll
                for (int e = 0; e < 4; ++e) { z0[e] = z0[e] * sigmoidf_(z0[e]); z1[e] = z1[e] * sigmoidf_(z1[e]); }
                *(GAS v4u*)(mix_base + (size_t)(row0 + q) * DM + 8 * lane) = pack8(z0, z1); } }
        return; }
    for (int rr = 0; rr < rpw; ++rr) { const int row = rpw * w + rr; if (row >= nrows) break;
        f32x4 y0 = *(const LAS f32x4*)(ybuf + row * 512 + 8 * lane), y1 = *(const LAS f32x4*)(ybuf + row * 512 + 8 * lane + 4);
        const float mu = wave_sum((y0[0] + y0[1]) + (y0[2] + y0[3]) + (y1[0] + y1[1]) + (y1[2] + y1[3])) * (1.0f / CCH);
        y0 -= mu; y1 -= mu;
        const float var = wave_sum((y0[0] * y0[0] + y0[1] * y0[1]) + (y0[2] * y0[2] + y0[3] * y0[3]) + (y1[0] * y1[0] + y1[1] * y1[1]) + (y1[2] * y1[2] + y1[3] * y1[3])) * (1.0f / CCH);
        const float rstd = 1.0f / sqrtf(var + EPS);
        f32x4 z0 = y0 * rstd * g0 + b0, z1 = y1 * rstd * g1 + b1;
#pragma unroll
        for (int e = 0; e < 4; ++e) { z0[e] = z0[e] * sigmoidf_(z0[e]); z1[e] = z1[e] * sigmoidf_(z1[e]); }
        *(GAS v4u*)(mix_base + (size_t)row * DM + 8 * lane) = pack8(z0, z1); }
}
__device__ __forceinline__ void conv_unit_prompt(const Args& A, LAS unsigned char* lds, int unit, int tid) {
    asm volatile("" : "+v"(tid));
    const int b = unit >> 6, half = tid >> 8, c = 2 * (tid & 255), t0 = (unit & 63) * 64 + 32 * half;
    const bf16* a = (const bf16*)(A.ws + WS_AGLU) + (size_t)b * SEQ * CCH + c;
    const float* cw = A.in[19] + c; f32x2 w[CONVW];
#pragma unroll
    for (int k = 0; k < CONVW; ++k) w[k] = *(const GAS f32x2*)(cw + k * CCH);
    const f32x2 bias = *(const GAS f32x2*)(A.in[20] + c);
    unsigned raw[64];
#pragma unroll
    for (int i = 0; i < 64; ++i) { const int t = t0 - 32 + i; raw[i] = *(const GAS unsigned*)(a + (size_t)(t >= 0 ? t : 0) * CCH); }
    f32x2 win[32];
#pragma unroll
    for (int i = 0; i < 32; ++i) { const int t = t0 - 32 + i; win[i] = (t >= 0) ? (f32x2){bflo(raw[i]), bfhi(raw[i])} : (f32x2){0.f, 0.f}; }
    LAS float* ybuf = (LAS float*)lds + (size_t)half * 32 * 512;
#pragma unroll
    for (int i = 0; i < 32; ++i) { win[i] = (f32x2){bflo(raw[32 + i]), bfhi(raw[32 + i])};
        f32x2 y = bias;
#pragma unroll
        for (int k = 0; k < CONVW; ++k) y += w[k] * win[(i - 30 + k) & 31];
        *(LAS f32x2*)(ybuf + i * 512 + c) = y; }
    __syncthreads();
    conv_ln_rows(A, (LAS float*)lds, 64, (bf16*)(A.ws + WS_MIX) + (size_t)(b * SEQ + (unit & 63) * 64) * DM + 512, tid);
    __syncthreads();
}
__device__ __forceinline__ void conv_unit_sample(const Args& A, LAS unsigned char* lds, int s, int tid) {
    asm volatile("" : "+v"(tid));
    const int c = tid; const float* zs = (const float*)(A.ws + WS_ZS) + (size_t)s * NIN;
    const int R1 = 1280 + (c >> 7) * 256 + (c & 127);
    const float anew = zs[R1] * sigmoidf_(zs[R1 + 128]);
    const float* st = A.in[5] + (size_t)s * 30 * CCH + c; const float* cw = A.in[19] + c;
    float y = A.in[20][c]; float* oc = A.out + O_CONV_S + (size_t)s * 30 * CCH + c;
    float e[30], wv[31];
#pragma unroll
    for (int k = 0; k < 30; ++k) { e[k] = *(const GAS float*)(st + k * CCH); wv[k] = *(const GAS float*)(cw + k * CCH); }
    wv[30] = *(const GAS float*)(cw + 30 * CCH);
#pragma unroll
    for (int k = 0; k < 30; ++k) { y += wv[k] * e[k]; if (k >= 1) *(GAS float*)(oc + (k - 1) * CCH) = e[k]; }
    y += wv[30] * anew; oc[29 * CCH] = anew;
    LAS float* ybuf = (LAS float*)lds; ybuf[c] = y;
    __syncthreads();
    conv_ln_rows(A, ybuf, 1, (bf16*)(A.ws + WS_MIXS) + (size_t)s * DM + 512, tid);
    __syncthreads();
}

__device__ __forceinline__ void pool_prep_unit(const Args& A, int unit, int tid) {
    asm volatile("" : "+v"(tid));
    const int b = unit >> 6, t0 = (unit & 63) * 64, c = 2 * tid, gi = c >> 8;
    const bf16* XBp = (const bf16*)(A.ws + WS_XB) + (size_t)b * SEQ * DM + c; const float* rs = (const float*)(A.ws + WS_ROWSS) + 1 * RS_STRIDE + b * SEQ;
    bf16* Z = (bf16*)(A.ws + WS_Z) + (size_t)b * SEQ * DM + c;
    const f32x2 g = *(const GAS f32x2*)(A.in[8] + DM + c);
    const float wl = (float)(2 << gi);
    f32x2 win[16];
#pragma unroll
    for (int i = 0; i < 16; ++i) win[i] = (f32x2){0.f, 0.f};
    unsigned xw[16], xn[16]; float rv[16], rn[16];
#pragma unroll
    for (int i = 0; i < 16; ++i) { const int t = t0 - 16 + i; const int tc = t >= 0 ? t : 0; xn[i] = *(const GAS unsigned*)(XBp + (size_t)tc * DM); rn[i] = *(const GAS float*)(rs + tc); }
#pragma unroll 1
    for (int blk = -1; blk < 4; ++blk) {
#pragma unroll
        for (int i = 0; i < 16; ++i) { xw[i] = xn[i]; rv[i] = rn[i]; }
        if (blk < 3) {
#pragma unroll
            for (int i = 0; i < 16; ++i) { const int t = t0 + (blk + 1) * 16 + i; xn[i] = *(const GAS unsigned*)(XBp + (size_t)t * DM); rn[i] = *(const GAS float*)(rs + t); } }
#pragma unroll
        for (int i = 0; i < 16; ++i) { const int t = t0 + blk * 16 + i;
            f32x2 h = (f32x2){0.f, 0.f};
            if (t >= 0) { const float rstd = __builtin_amdgcn_rsqf(rv[i] * (1.0f / DM) + EPS); h = (f32x2){bflo(xw[i]), bfhi(xw[i])} * rstd * g; }
            win[i] = h;
            if (blk >= 0) {
                f32x2 s2 = h + win[(i - 1) & 15];
                f32x2 s4 = s2 + win[(i - 2) & 15] + win[(i - 3) & 15];
                f32x2 s8 = s4 + (win[(i - 4) & 15] + win[(i - 5) & 15]) + (win[(i - 6) & 15] + win[(i - 7) & 15]);
                f32x2 s16 = s8 + ((win[(i - 8) & 15] + win[(i - 9) & 15]) + (win[(i - 10) & 15] + win[(i - 11) & 15])) + ((win[(i - 12) & 15] + win[(i - 13) & 15]) + (win[(i - 14) & 15] + win[(i - 15) & 15]));
                const f32x2 sw = gi == 0 ? s2 : gi == 1 ? s4 : gi == 2 ? s8 : s16;
                const float cnt = fminf(wl, (float)(t + 1));
                const f32x2 z = sw * (1.0f / cnt) - h;
                *(GAS unsigned*)(Z + (size_t)t * DM) = pg8::cvt_pk_bf16(z.x, z.y);
                if (t >= SEQ - POOLB) *(GAS f32x2*)(A.out + O_POOL_P + ((size_t)(b * POOLB + t - (SEQ - POOLB)) * DM + c)) = h;
            } }
    }
}
__device__ __forceinline__ void pool_prep_sample(const Args& A, int s, int tid) {
    asm volatile("" : "+v"(tid));
    const int c = 2 * tid, gi = c >> 8; const int wl = 2 << gi;
    const float rstd = __builtin_amdgcn_rsqf(((const float*)(A.ws + WS_ROWSS))[1 * RS_STRIDE + MP + s] * (1.0f / DM) + EPS);
    const f32x2 g = *(const GAS f32x2*)(A.in[8] + DM + c);
    const f32x2 h = *(const GAS f32x2*)((const float*)(A.ws + WS_XRS) + (size_t)s * DM + c) * rstd * g;
    const float* st = A.in[6] + (size_t)s * POOLB * DM + c; float* op = A.out + O_POOL_S + (size_t)s * POOLB * DM + c;
    f32x2 sw = h, e[POOLB];
#pragma unroll
    for (int k = 0; k < POOLB; ++k) e[k] = *(const GAS f32x2*)(st + (size_t)k * DM);
#pragma unroll
    for (int k = 0; k < POOLB; ++k) {
        if (15 - k < wl) sw += e[k];
        if (k >= 1) *(GAS f32x2*)(op + (size_t)(k - 1) * DM) = e[k]; }
    *(GAS f32x2*)(op + (size_t)(POOLB - 1) * DM) = h;
    const f32x2 z = sw * (1.0f / (float)wl) - h;
    *(GAS unsigned*)((bf16*)(A.ws + WS_ZPS) + (size_t)s * DM + c) = pg8::cvt_pk_bf16(z.x, z.y);
}
constexpr int PL_H = 0, PL_Z = 81920, PL_END = PL_Z + 32768;
static_assert(PL_END + 2048 <= RING_BYTES && 80 * 1024 <= PL_Z, "pooling LDS");
__device__ __forceinline__ void pool_fused_wg(const Args& A, LAS unsigned char* lds, int g, int wgi, int tid) {
    asm volatile("" : "+v"(tid));
    const int lane = tid & 63, wave = __builtin_amdgcn_readfirstlane(tid >> 6), r32 = lane & 31, hi = lane >> 5;
    unsigned char* ws = A.ws;
    const bf16* XBo = (const bf16*)(ws + WS_XB); bf16* XBn = (bf16*)(ws + WS_XR);
    float* rs_in = (float*)(ws + WS_ROWSS) + 1 * RS_STRIDE; float* rs_out = (float*)(ws + WS_ROWSS) + 2 * RS_STRIDE;
    LAS float* H = (LAS float*)(lds + PL_H); LAS unsigned char* Zt = lds + PL_Z;
    bf16x8 wf[16];
    { const bf16* wt = (const bf16*)(ws + WS_POOL_T) + (size_t)g * 65536 + (size_t)(32 * wave + r32) * 256 + 8 * hi;
#pragma unroll
      for (int ks = 0; ks < 16; ++ks) wf[ks] = *(const GAS bf16x8*)(wt + 16 * ks); }
    const int c8 = tid & 31;
    LAS float* GL = (LAS float*)(lds + PL_END);
    f32x4 glv = (f32x4){0.f, 0.f, 0.f, 0.f};
    if (tid < 64) glv = *(const GAS f32x4*)(A.in[8] + DM + g * 256 + 4 * tid);
    else if (tid < 128) glv = *(const GAS f32x4*)(A.in[24] + g * 256 + 4 * (tid - 64));
    const int w = 2 << g; const float invw = 1.0f / (float)w;
#define PL_BAR() asm volatile("s_waitcnt lgkmcnt(0)\n\ts_barrier" ::: "memory")
#define PL_SWZ(X) ss += __int_as_float(__builtin_amdgcn_ds_swizzle(__float_as_int(ss), ((X) << 10) | 0x1F))
    const int b = wgi >> 3, R0 = (wgi & 7) * 512, r16 = tid >> 5;
    const size_t rowb = (size_t)b * SEQ;
    const bf16* xcol = XBo + rowb * DM + g * 256 + 8 * c8; const float* rsb = rs_in + rowb;
    v4u pb[3][4]; float pr[3][4];
    const bf16* xld = xcol + (size_t)(R0 + r16) * DM; const float* rld = rsb + R0 + r16;
#define PL_LOAD(UU) do { asm volatile("" : "+v"(xld), "+v"(rld)); _Pragma("unroll") for (int j = 0; j < 4; ++j) { \
        pb[(UU) % 3][j] = *(const GAS v4u*)(xld + (size_t)(16 * j) * DM); pr[(UU) % 3][j] = *(const GAS float*)(rld + 16 * j); } xld += 64 * DM; rld += 64; } while (0)
    pb[2][3] = (v4u){0u, 0u, 0u, 0u}; pr[2][3] = 0.f;
    if (R0 > 0) { const int t = R0 - 16 + r16; pb[2][3] = *(const GAS v4u*)(xcol + (size_t)t * DM); pr[2][3] = *(const GAS float*)(rsb + t); }
    PL_LOAD(0); PL_LOAD(1);
    if (tid < 128) *(LAS f32x4*)(GL + 4 * tid) = glv;
    __syncthreads();
#pragma unroll
    for (int u = 0; u < 8; ++u) {
        const int R = R0 + 64 * u;
        { const f32x4 ga = *(const LAS f32x4*)(GL + 8 * c8), gb = *(const LAS f32x4*)(GL + 8 * c8 + 4);
          f32x4 h0 = (f32x4){0.f, 0.f, 0.f, 0.f}, h1 = h0;
          if (R > 0) { const v4u hal = pb[(u + 2) % 3][3]; const float rstd = __builtin_amdgcn_rsqf(pr[(u + 2) % 3][3] * (1.0f / DM) + EPS);
              h0 = (f32x4){bflo(hal.x), bfhi(hal.x), bflo(hal.y), bfhi(hal.y)} * rstd * ga; h1 = (f32x4){bflo(hal.z), bfhi(hal.z), bflo(hal.w), bfhi(hal.w)} * rstd * gb; }
          *(LAS f32x4*)(H + r16 * 256 + 8 * c8) = h0; *(LAS f32x4*)(H + r16 * 256 + 8 * c8 + 4) = h1;
#pragma unroll
          for (int j = 0; j < 4; ++j) { const int i = 16 + r16 + 16 * j; const v4u xw = pb[u % 3][j]; const float rstd = __builtin_amdgcn_rsqf(pr[u % 3][j] * (1.0f / DM) + EPS);
              h0 = (f32x4){bflo(xw.x), bfhi(xw.x), bflo(xw.y), bfhi(xw.y)} * rstd * ga; h1 = (f32x4){bflo(xw.z), bfhi(xw.z), bflo(xw.w), bfhi(xw.w)} * rstd * gb;
              *(LAS f32x4*)(H + i * 256 + 8 * c8) = h0; *(LAS f32x4*)(H + i * 256 + 8 * c8 + 4) = h1; } }
        if (u + 2 < 8) PL_LOAD(u + 2);
        PL_BAR();
        { int tq = tid; asm volatile("" : "+v"(tq));
          const int cp = tq & 127, rq = tq >> 7, i0 = 16 * rq + 16;
          f32x2 sacc = (f32x2){0.f, 0.f};
          { f32x2 iv[15];
#pragma unroll
            for (int d = 1; d < 16; ++d) iv[d - 1] = *(const LAS f32x2*)(H + (i0 - d) * 256 + 2 * cp);
            __builtin_amdgcn_sched_barrier(0);
            const f32x2 s1 = iv[0], s3 = s1 + (iv[1] + iv[2]), s7 = s3 + ((iv[3] + iv[4]) + (iv[5] + iv[6])), s15 = s7 + (((iv[7] + iv[8]) + (iv[9] + iv[10])) + ((iv[11] + iv[12]) + (iv[13] + iv[14])));
            sacc = (w == 2) ? s1 : (w == 4) ? s3 : (w == 8) ? s7 : s15; }
          const bool special = (u == 0 && R == 0) || (u == 7 && R == SEQ - 64);
          if (!special) {
              const LAS float* hb = H + i0 * 256 + 2 * cp; const LAS float* hs = hb - (w - 1) * 256;
              LAS unsigned char* zb = Zt + (16 * rq) * 512 + (cp & 3) * 4; const int cq = (cp >> 2) << 4;
#pragma unroll
              for (int kb = 0; kb < 16; kb += 8) { f32x2 hv[8], sv[8];
#pragma unroll
                  for (int k = 0; k < 8; ++k) { hv[k] = *(const LAS f32x2*)(hb + (kb + k) * 256); sv[k] = *(const LAS f32x2*)(hs + (kb + k) * 256); }
                  __builtin_amdgcn_sched_barrier(0);
#pragma unroll
                  for (int k = 0; k < 8; ++k) { sacc += hv[k];
                      const f32x2 z = sacc * invw - hv[k];
                      *(LAS unsigned*)(zb + (kb + k) * 512 + (cq ^ ((kb + k) << 4))) = pg8::cvt_pk_bf16(z.x, z.y);
                      sacc -= sv[k]; }
                  __builtin_amdgcn_sched_barrier(0); }
          } else {
#pragma unroll 8
          for (int k = 0; k < 16; ++k) { const int i = i0 + k, r = 16 * rq + k, t = R + r;
              const f32x2 h = *(const LAS f32x2*)(H + i * 256 + 2 * cp);
              sacc += h;
              const float cnt = fminf((float)w, (float)(t + 1));
              const f32x2 z = sacc * (1.0f / cnt) - h;
              *(LAS unsigned*)(Zt + r * 512 + ((((2 * cp) >> 3) ^ (r & 15)) << 4) + ((2 * cp) & 7) * 2) = pg8::cvt_pk_bf16(z.x, z.y);
              if (t >= SEQ - POOLB) *(GAS f32x2*)(A.out + O_POOL_P + ((size_t)(b * POOLB + t - (SEQ - POOLB)) * DM + g * 256 + 2 * cp)) = h;
              sacc -= *(const LAS f32x2*)(H + (i - w + 1) * 256 + 2 * cp); } } }
        PL_BAR();
        f32x16 acc[2];
#pragma unroll
        for (int e = 0; e < 16; ++e) { acc[0][e] = 0.f; acc[1][e] = 0.f; }
        { bf16x8 af[2][2];
#define PL_AF(KS) do { _Pragma("unroll") for (int rb = 0; rb < 2; ++rb) { const int row = 32 * rb + r32; af[(KS) & 1][rb] = *(const LAS bf16x8*)(Zt + row * 512 + (((2 * (KS) + hi) ^ (row & 15)) << 4)); } } while (0)
          PL_AF(0);
#pragma unroll
          for (int ks = 0; ks < 16; ++ks) {
              if (ks + 1 < 16) PL_AF(ks + 1);
              __builtin_amdgcn_sched_barrier(0);
#pragma unroll
              for (int rb = 0; rb < 2; ++rb) acc[rb] = __builtin_amdgcn_mfma_f32_32x32x16_bf16(af[ks & 1][rb], wf[ks], acc[rb], 0, 0, 0);
              __builtin_amdgcn_sched_barrier(0); }
#undef PL_AF
        }
#pragma unroll
        for (int rb = 0; rb < 2; ++rb)
#pragma unroll
            for (int e = 0; e < 16; ++e) H[(32 * rb + (e & 3) + 8 * (e >> 2) + 4 * hi) * 256 + 32 * wave + r32] = acc[rb][e];
        PL_BAR();
        { const f32x4 sa = *(const LAS f32x4*)(GL + 256 + 8 * c8), sb = *(const LAS f32x4*)(GL + 256 + 8 * c8 + 4);
          float ssv[4];
#pragma unroll
          for (int j = 0; j < 4; ++j) { const int row = r16 + 16 * j; const size_t off = (rowb + R + row) * DM + g * 256 + 8 * c8;
            const v4u xw = pb[u % 3][j];
            const f32x4 p0 = *(const LAS f32x4*)(H + row * 256 + 8 * c8), p1 = *(const LAS f32x4*)(H + row * 256 + 8 * c8 + 4);
            const f32x4 v0 = (f32x4){bflo(xw.x), bfhi(xw.x), bflo(xw.y), bfhi(xw.y)} + p0 * sa, v1 = (f32x4){bflo(xw.z), bfhi(xw.z), bflo(xw.w), bfhi(xw.w)} + p1 * sb;
            *(GAS v4u*)(XBn + off) = pack8(v0, v1);
            ssv[j] = (v0[0] * v0[0] + v0[1] * v0[1]) + (v0[2] * v0[2] + v0[3] * v0[3]) + (v1[0] * v1[0] + v1[1] * v1[1]) + (v1[2] * v1[2] + v1[3] * v1[3]); }
#define PL_LVL(X) do { float tv[4]; _Pragma("unroll") for (int j = 0; j < 4; ++j) tv[j] = __int_as_float(__builtin_amdgcn_ds_swizzle(__float_as_int(ssv[j]), ((X) << 10) | 0x1F)); \
                       _Pragma("unroll") for (int j = 0; j < 4; ++j) ssv[j] += tv[j]; } while (0)
          PL_LVL(1); PL_LVL(2); PL_LVL(4); PL_LVL(8); PL_LVL(16);
#undef PL_LVL
          if (c8 == 0) {
#pragma unroll
              for (int j = 0; j < 4; ++j) atomic_addf(rs_out + rowb + R + r16 + 16 * j, ssv[j]); } }
        PL_BAR();
    }
    __syncthreads();
#undef PL_LOAD
#undef PL_BAR
#undef PL_SWZ
}
__device__ __forceinline__ void final_row(const float* xrow, float ss, const float* gain, float* orow, int lane) {
    const float rstd = 1.0f / sqrtf(ss * (1.0f / DM) + EPS);
    const GAS f32x4* xr = (const GAS f32x4*)xrow + lane; const GAS f32x4* gr = (const GAS f32x4*)gain + lane; GAS f32x4* o = (GAS f32x4*)orow + lane;
    f32x4 xv[4], gv[4];
#pragma unroll
    for (int j = 0; j < 4; ++j) { xv[j] = xr[64 * j]; gv[j] = gr[64 * j]; }
#pragma unroll
    for (int j = 0; j < 4; ++j) o[64 * j] = xv[j] * rstd * gv[j];
}
__device__ __forceinline__ void final_row_bf16(const bf16* xrow, float ss, const float* gain, float* orow, int lane) {
    const float rstd = 1.0f / sqrtf(ss * (1.0f / DM) + EPS);
    const GAS v4u* xr = (const GAS v4u*)xrow + lane; const GAS f32x4* gr = (const GAS f32x4*)gain + 2 * lane; GAS f32x4* o = (GAS f32x4*)orow + 2 * lane;
#pragma unroll
    for (int j = 0; j < 2; ++j) { const v4u w = xr[64 * j];
        o[128 * j] = (f32x4){bflo(w.x), bfhi(w.x), bflo(w.y), bfhi(w.y)} * rstd * gr[128 * j]; o[128 * j + 1] = (f32x4){bflo(w.z), bfhi(w.z), bflo(w.w), bfhi(w.w)} * rstd * gr[128 * j + 1]; }
}

constexpr int AT_KV = 0, AT_KVB = 16640  , AT_SLOT = 16384  ,
              AT_WSF = 4 * AT_SLOT, AT_SA = AT_WSF + 2048, AT_SB = AT_SA + 64 * 65 * 4, AT_SS = AT_SB + 64 * 65 * 4,
              AT_SEL = AT_SS + 64 * 64 * 4, AT_END = AT_SA + 8 * 8192;
static_assert(AT_END <= RING_BYTES && AT_SEL + 512 <= AT_END, "attention LDS");
__device__ __forceinline__ int crow(int r, int hi) { return (r & 3) + 8 * (r >> 2) + 4 * hi; }
__device__ __forceinline__ float xhalf_max(float m) { auto rr = __builtin_amdgcn_permlane32_swap(__float_as_uint(m), __float_as_uint(m), false, false); return fmaxf(__uint_as_float(rr[0]), __uint_as_float(rr[1])); }
__device__ __forceinline__ float xhalf_sum(float m) { auto rr = __builtin_amdgcn_permlane32_swap(__float_as_uint(m), __float_as_uint(m), false, false); return __uint_as_float(rr[0]) + __uint_as_float(rr[1]); }
typedef short v4i16_t __attribute__((ext_vector_type(4)));
__device__ __forceinline__ s16x4 vtr(const LAS unsigned char* p) { return __builtin_bit_cast(s16x4, __builtin_amdgcn_ds_read_tr16_b64_v4i16((LAS v4i16_t*)p)); }

struct KVTile { v4u k, v; };
__device__ __forceinline__ KVTile kv_gload(const bf16* Kg, const bf16* Vg, int pitch, int row0, int tid) {
    const int key = tid >> 3, c = tid & 7; KVTile t;
    t.k = *(const GAS v4u*)(Kg + (size_t)(row0 + key) * pitch + c * 8); t.v = *(const GAS v4u*)(Vg + (size_t)(row0 + key) * pitch + c * 8); return t;
}
__device__ __forceinline__ void kv_lwrite(LAS unsigned char* buf, const KVTile& t, int tid) {
    const int key = tid >> 3, c = tid & 7;
    *(LAS v4u*)(buf + c * 1040 + key * 16) = t.k;
    *(LAS v4u*)(buf + 8320 + (c >> 2) * 4160 + key * 64 + (c & 3) * 16) = t.v;
}
struct SmState { float m, l; bool seen; };
template <int MODE>
__device__ __forceinline__ void attn_tile(const LAS unsigned char* buf, const bf16x8 (&qf)[4], SmState& S, f32x16 (&o)[2], int lo, int hi_, bool tilefull, float invl,
                                         LAS float* wsf, LAS float* sA, LAS float* sB, int jbase, int qrow, int lane) {
    const int r32 = lane & 31, hi = lane >> 5;
    const bool laneon = hi_ >= lo;
    const float cinit = (MODE == 1) ? -S.m : (laneon ? -S.m : -INFINITY);
    f32x16 p0, p1; int c0t;
#pragma unroll
    for (int e = 0; e < 16; ++e) { p0[e] = cinit; p1[e] = cinit; }
#pragma unroll
    for (int s = 0; s < 4; ++s) {
        const int sw_ = (r32 >> 1) & 7;
        const bf16x8 k0 = *(const LAS bf16x8*)(buf + r32 * 128 + (((2 * s + hi) ^ sw_) << 4)), k1 = *(const LAS bf16x8*)(buf + (32 + r32) * 128 + (((2 * s + hi) ^ sw_) << 4));
        p0 = __builtin_amdgcn_mfma_f32_32x32x16_bf16(k0, qf[s], p0, 0, 0, 0); p1 = __builtin_amdgcn_mfma_f32_32x32x16_bf16(k1, qf[s], p1, 0, 0, 0);
    }
    if (!tilefull) {
        const int lo2 = laneon ? lo : 64, R = laneon ? hi_ - lo : 0, kb0 = 4 * hi - lo2; const float ninf = -INFINITY;
#pragma unroll
        for (int e = 0; e < 16; ++e) { const int c0 = (e & 3) + 8 * (e >> 2);
            asm volatile("v_add_u32 %0, %2, %3\n\tv_cmp_gt_u32 vcc, %0, %4\n\tv_cndmask_b32 %1, %1, %5, vcc" : "=&v"(c0t), "+v"(p0[e]) : "v"(kb0), "n"(c0), "v"(R), "v"(ninf) : "vcc");
            asm volatile("v_add_u32 %0, %2, %3\n\tv_cmp_gt_u32 vcc, %0, %4\n\tv_cndmask_b32 %1, %1, %5, vcc" : "=&v"(c0t), "+v"(p1[e]) : "v"(kb0), "n"(c0 + 32), "v"(R), "v"(ninf) : "vcc"); }
    }
    if (MODE != 1) {
        float rm = fmaxf(p0[0], p1[0]);
#pragma unroll
        for (int e = 1; e < 16; ++e) rm = fmaxf(rm, fmaxf(p0[e], p1[e]));
        rm = xhalf_max(rm);
        const bool valid = rm > -INFINITY;
        const bool need = S.seen ? (rm > 8.0f) : (valid && (rm > 8.0f || rm < -8.0f));
        if (__any(need)) {
            float dl = 0.f, f = 1.f;
            if (valid) { if (!S.seen) dl = rm; else if (rm > 0.f) { dl = rm; f = fexp2(-dl); } }
            S.m += dl; S.l *= f;
#pragma unroll
            for (int e = 0; e < 16; ++e) { p0[e] -= dl; p1[e] -= dl; }
            if (MODE == 2) {
                if (hi == 0) wsf[r32] = f;
                LDS_WAIT(); asm volatile("" ::: "memory");
#pragma unroll
                for (int e = 0; e < 16; ++e) { const float fr_ = wsf[crow(e, hi)]; o[0][e] *= fr_; o[1][e] *= fr_; }
                LDS_WAIT(); asm volatile("" ::: "memory");
            }
        }
        S.seen = S.seen || valid;
    }
    float ls = 0.f;
#pragma unroll
    for (int e = 0; e < 16; ++e) { p0[e] = fexp2(p0[e]); p1[e] = fexp2(p1[e]); ls += p0[e] + p1[e]; }
    if (MODE != 1) S.l += ls;
    if (MODE == 0) return;
    if (MODE == 1) {
#pragma unroll
        for (int e = 0; e < 16; ++e) { p0[e] *= invl; p1[e] *= invl; }
#pragma unroll
        for (int kb = 0; kb < 2; ++kb)
#pragma unroll
            for (int i = 0; i < 4; ++i) { const f32x16& p = kb ? p1 : p0;
                float a = 2.0f * (p[4 * i] + p[4 * i + 1] + p[4 * i + 2]) + p[4 * i + 3], bq = p[4 * i + 3];
                a += __shfl_xor(a, 1); a += __shfl_xor(a, 2); bq += __shfl_xor(bq, 1); bq += __shfl_xor(bq, 2);
                const int j = jbase + 8 * kb + 2 * i + hi;
                if ((lane & 3) == 0) { sA[qrow * 65 + j] = a; sB[qrow * 65 + j + 1] = bq; } }
    }
    bf16x8 pa[4];
#pragma unroll
    for (int ks = 0; ks < 4; ++ks) { const f32x16& p = (ks >> 1) ? p1 : p0; const int b8 = 8 * (ks & 1);
        v4u w; w.x = pg8::cvt_pk_bf16(p[b8], p[b8 + 1]); w.y = pg8::cvt_pk_bf16(p[b8 + 2], p[b8 + 3]); w.z = pg8::cvt_pk_bf16(p[b8 + 4], p[b8 + 5]); w.w = pg8::cvt_pk_bf16(p[b8 + 6], p[b8 + 7]);
        pa[ks] = __builtin_bit_cast(bf16x8, w); }
    const LAS unsigned char* vb = buf + 8192 + ((lane >> 4) & 1) * 32 + (lane & 3) * 8 + (4 * hi + ((lane & 15) >> 2)) * 64;
#pragma unroll
    for (int d0 = 0; d0 < 2; ++d0)
#pragma unroll
        for (int ks = 0; ks < 4; ++ks) { const s16x4 vl = vtr(vb + d0 * 4096 + ks * 1024), vh = vtr(vb + d0 * 4096 + ks * 1024 + 512);
            const bf16x8 vf = (bf16x8){vl[0], vl[1], vl[2], vl[3], vh[0], vh[1], vh[2], vh[3]};
            o[d0] = __builtin_amdgcn_mfma_f32_32x32x16_bf16(pa[ks], vf, o[d0], 0, 0, 0); }
}
template <int PITCH = 256>
__device__ __forceinline__ void kv_dma(const bf16* Kg, const bf16* Vg, int row0, LAS unsigned char* slot, int w, int lane) {
    const int kkey = 8 * w + (lane >> 3), kc = (lane & 7) ^ ((kkey >> 1) & 7);
    __builtin_amdgcn_global_load_lds((const unsigned*)(Kg + (size_t)(row0 + kkey) * PITCH + kc * 8), (LAS unsigned*)(slot + w * 1024), 16, 0, 0);
    const int vkey = 16 * (w & 3) + (lane >> 2);
    __builtin_amdgcn_global_load_lds((const unsigned*)(Vg + (size_t)(row0 + vkey) * PITCH + (w >> 2) * 32 + (lane & 3) * 8), (LAS unsigned*)(slot + 8192 + w * 1024), 16, 0, 0);
}
__device__ __forceinline__ void qk_ring(f32x16& p0, f32x16& p1, const LAS unsigned char* slot, const bf16x8 (&qf)[4], float mref, int r32, int hi) {
    const int sw = (r32 >> 1) & 7; f32x16 negm;
#pragma unroll
    for (int e = 0; e < 16; ++e) negm[e] = -mref;
#pragma unroll
    for (int s = 0; s < 4; ++s) {
        const bf16x8 k0 = *(const LAS bf16x8*)(slot + r32 * 128 + (((2 * s + hi) ^ sw) << 4)), k1 = *(const LAS bf16x8*)(slot + (32 + r32) * 128 + (((2 * s + hi) ^ sw) << 4));
        if (s == 0) { p0 = __builtin_amdgcn_mfma_f32_32x32x16_bf16(k0, qf[0], negm, 0, 0, 0); p1 = __builtin_amdgcn_mfma_f32_32x32x16_bf16(k1, qf[0], negm, 0, 0, 0); }
        else { p0 = __builtin_amdgcn_mfma_f32_32x32x16_bf16(k0, qf[s], p0, 0, 0, 0); p1 = __builtin_amdgcn_mfma_f32_32x32x16_bf16(k1, qf[s], p1, 0, 0, 0); }
    }
}
__device__ __forceinline__ float mask_max(f32x16& p0, f32x16& p1, bool edge, bool flag, int lo, int hi_, int hi) {
    if (edge) { const bool on = hi_ >= lo; const int lo2 = on ? lo : 64, R = on ? hi_ - lo : 0, kb0 = 4 * hi - lo2; const float ninf = -INFINITY; int c0t;
#pragma unroll
        for (int e = 0; e < 16; ++e) { const int c0 = (e & 3) + 8 * (e >> 2);
            asm volatile("v_add_u32 %0, %2, %3\n\tv_cmp_gt_u32 vcc, %0, %4\n\tv_cndmask_b32 %1, %1, %5, vcc" : "=&v"(c0t), "+v"(p0[e]) : "v"(kb0), "n"(c0), "v"(R), "v"(ninf) : "vcc");
            asm volatile("v_add_u32 %0, %2, %3\n\tv_cmp_gt_u32 vcc, %0, %4\n\tv_cndmask_b32 %1, %1, %5, vcc" : "=&v"(c0t), "+v"(p1[e]) : "v"(kb0), "n"(c0 + 32), "v"(R), "v"(ninf) : "vcc"); } }
    float rm = __builtin_elementwise_maximum(p0[0], p1[0]);
#pragma unroll
    for (int e = 1; e < 16; ++e) rm = __builtin_elementwise_maximum(rm, __builtin_elementwise_maximum(p0[e], p1[e]));
    rm = xhalf_max(rm);
    return flag ? rm : -INFINITY;
}
__device__ __forceinline__ void decide(f32x16& p0, f32x16& p1, float rm, SmState& S, f32x16 (&o)[2], LAS float* wsf, int r32, int hi) {
    const bool valid = rm > -INFINITY;
    const bool need = S.seen ? (rm > 8.0f) : (valid && (rm > 8.0f || rm < -8.0f));
    if (__any(need)) {
        float dl = 0.f, f = 1.f;
        if (valid) { if (!S.seen) dl = rm; else if (rm > 0.f) { dl = rm; f = fexp2(-dl); } }
        S.m += dl; S.l *= f;
#pragma unroll
        for (int e = 0; e < 16; ++e) { p0[e] -= dl; p1[e] -= dl; }
        if (hi == 0) wsf[r32] = f;
        LDS_WAIT(); asm volatile("" ::: "memory");
#pragma unroll
        for (int e = 0; e < 16; ++e) { const float fr_ = wsf[crow(e, hi)]; o[0][e] *= fr_; o[1][e] *= fr_; }
        LDS_WAIT(); asm volatile("" ::: "memory");
    }
    S.seen = S.seen || valid;
}
typedef float f32x2_t __attribute__((ext_vector_type(2))); typedef __bf16 bf16x2_t __attribute__((ext_vector_type(2)));
__device__ __forceinline__ unsigned cvtpk_s(float lo, float hi) { f32x2_t v = {lo, hi}; bf16x2_t b = __builtin_convertvector(v, bf16x2_t); return __builtin_bit_cast(unsigned, b); }
#define SBAR() __builtin_amdgcn_sched_barrier(0)
template <bool WIN>
__device__ __forceinline__ void attn_stream(LAS unsigned char* lds, const bf16* Kg, const bf16* Vg, int j0, int qt, unsigned sel_lo, unsigned sel_hi, const bf16x8 (&qf)[4], SmState& S, f32x16 (&o)[2],
                                           LAS float* wsf, int qloc, int w, int lane) {
    const int r32 = lane & 31, hi = lane >> 5, n = qt - j0 + 1;
    LAS unsigned char* ring = lds;
#define AT_FLAG(j) (WIN ? true : ((((j) < 32 ? sel_lo >> (j) : sel_hi >> ((j) - 32)) & 1u) != 0u))
#define AT_EDGE(j) (WIN ? ((j) == qt || (j) == qt - 8) : ((j) == qt))
#define AT_LO(j) ((WIN && (j) == qt - 8) ? qloc + 1 : 0)
#define AT_HI(j) (((j) == qt) ? qloc : 63)
    __syncthreads();
    kv_dma(Kg, Vg, 64 * j0, ring, w, lane);
    if (n > 1) kv_dma(Kg, Vg, 64 * (j0 + 1), ring + AT_SLOT, w, lane);
    if (n > 2) kv_dma(Kg, Vg, 64 * (j0 + 2), ring + 2 * AT_SLOT, w, lane);
    if (n > 2) asm volatile("s_waitcnt vmcnt(4)\n\ts_barrier" ::: "memory"); else if (n > 1) asm volatile("s_waitcnt vmcnt(2)\n\ts_barrier" ::: "memory"); else asm volatile("s_waitcnt vmcnt(0)\n\ts_barrier" ::: "memory");
    f32x16 s0, s1;
    qk_ring(s0, s1, ring, qf, AT_FLAG(j0) ? S.m : INFINITY, r32, hi);
    { const float rm = mask_max(s0, s1, AT_EDGE(j0), true, AT_LO(j0), AT_HI(j0), hi); decide(s0, s1, rm, S, o, wsf, r32, hi); }
    const LAS unsigned char* vb = ring + 8192 + ((lane >> 4) & 1) * 32 + (lane & 3) * 8 + (4 * hi + ((lane & 15) >> 2)) * 64;
    const int kro = r32 * 128, sw = (r32 >> 1) & 7;
#define AT_STEP(C0, C1, N0, N1, tt) do { const int t_ = (tt), j = j0 + t_; \
        if (t_ + 2 < n) asm volatile("s_waitcnt vmcnt(2) lgkmcnt(0)\n\ts_barrier" ::: "memory"); else asm volatile("s_waitcnt vmcnt(0) lgkmcnt(0)\n\ts_barrier" ::: "memory"); \
        if (t_ + 3 < n) kv_dma(Kg, Vg, 64 * (j + 3), ring + ((t_ + 3) & 3) * AT_SLOT, w, lane); \
        const LAS unsigned char* ks = ring + ((t_ + 1) & 3) * AT_SLOT + kro; \
        bf16x8 kf[8]; \
        _Pragma("unroll") for (int i = 0; i < 8; ++i) kf[i] = *(const LAS bf16x8*)(ks + (i & 1) * 4096 + (((2 * (i >> 1) + hi) ^ sw) << 4)); \
        f32x16 cin_; { const float c1_ = AT_FLAG(j + 1) ? -S.m : -INFINITY;         \
            _Pragma("unroll") for (int e = 0; e < 16; ++e) cin_[e] = c1_; } \
        float ls = 0.f; \
        SBAR(); __builtin_amdgcn_s_setprio(1); \
        _Pragma("unroll") for (int i = 0; i < 8; ++i) { \
            if (i == 0) N0 = __builtin_amdgcn_mfma_f32_32x32x16_bf16(kf[0], qf[0], cin_, 0, 0, 0); else if (i == 1) N1 = __builtin_amdgcn_mfma_f32_32x32x16_bf16(kf[1], qf[0], cin_, 0, 0, 0); \
            else if (i & 1) N1 = __builtin_amdgcn_mfma_f32_32x32x16_bf16(kf[i], qf[i >> 1], N1, 0, 0, 0); else N0 = __builtin_amdgcn_mfma_f32_32x32x16_bf16(kf[i], qf[i >> 1], N0, 0, 0, 0); \
            C0[2 * i] = fexp2(C0[2 * i]); C0[2 * i + 1] = fexp2(C0[2 * i + 1]); C1[2 * i] = fexp2(C1[2 * i]); C1[2 * i + 1] = fexp2(C1[2 * i + 1]); \
            ls += (C0[2 * i] + C0[2 * i + 1]) + (C1[2 * i] + C1[2 * i + 1]); \
            SBAR(); } \
        __builtin_amdgcn_s_setprio(0); \
        const LAS unsigned char* vbt = vb + (t_ & 3) * AT_SLOT; \
        s16x4 vl[8], vh[8]; \
        _Pragma("unroll") for (int i = 0; i < 8; ++i) { vl[i] = vtr(vbt + (i >> 2) * 4096 + (i & 3) * 1024); vh[i] = vtr(vbt + (i >> 2) * 4096 + (i & 3) * 1024 + 512); } \
        SBAR(); \
        S.l += ls; \
        bf16x8 pa[4]; \
        _Pragma("unroll") for (int ks2 = 0; ks2 < 4; ++ks2) { const f32x16& p = (ks2 >> 1) ? C1 : C0; const int b8 = 8 * (ks2 & 1); \
            v4u wv; wv.x = cvtpk_s(p[b8], p[b8 + 1]); wv.y = cvtpk_s(p[b8 + 2], p[b8 + 3]); wv.z = cvtpk_s(p[b8 + 4], p[b8 + 5]); wv.w = cvtpk_s(p[b8 + 6], p[b8 + 7]); \
            pa[ks2] = __builtin_bit_cast(bf16x8, wv); } \
        SBAR(); __builtin_amdgcn_s_setprio(1); \
        _Pragma("unroll") for (int ks2 = 0; ks2 < 4; ++ks2) \
            _Pragma("unroll") for (int d0 = 0; d0 < 2; ++d0) { const int i = d0 * 4 + ks2; \
                const bf16x8 vf = (bf16x8){vl[i][0], vl[i][1], vl[i][2], vl[i][3], vh[i][0], vh[i][1], vh[i][2], vh[i][3]}; \
                o[d0] = __builtin_amdgcn_mfma_f32_32x32x16_bf16(pa[ks2], vf, o[d0], 0, 0, 0); } \
        __builtin_amdgcn_s_setprio(0); \
        { const int jn = j + 1; \
          const float rm = mask_max(N0, N1, AT_EDGE(jn), true, AT_LO(jn), AT_HI(jn), hi); \
          decide(N0, N1, rm, S, o, wsf, r32, hi); } \
    } while (0)
    f32x16 n0, n1;
    int t = 0;
#pragma unroll 1
    for (; t + 2 < n; t += 2) { AT_STEP(s0, s1, n0, n1, t); AT_STEP(n0, n1, s0, s1, t + 1); }
    if (t + 1 < n) { AT_STEP(s0, s1, n0, n1, t); s0 = n0; s1 = n1; }
#undef AT_STEP
    { const int t = n - 1;
      float ls = 0.f;
#pragma unroll
      for (int e = 0; e < 16; ++e) { s0[e] = fexp2(s0[e]); s1[e] = fexp2(s1[e]); ls += s0[e] + s1[e]; }
      S.l += ls;
      const LAS unsigned char* vbt = vb + (t & 3) * AT_SLOT;
#pragma unroll
      for (int ks2 = 0; ks2 < 4; ++ks2) { const f32x16& p = (ks2 >> 1) ? s1 : s0; const int b8 = 8 * (ks2 & 1);
          v4u wv; wv.x = cvtpk_s(p[b8], p[b8 + 1]); wv.y = cvtpk_s(p[b8 + 2], p[b8 + 3]); wv.z = cvtpk_s(p[b8 + 4], p[b8 + 5]); wv.w = cvtpk_s(p[b8 + 6], p[b8 + 7]);
          const bf16x8 pa = __builtin_bit_cast(bf16x8, wv);
#pragma unroll
          for (int d0 = 0; d0 < 2; ++d0) { const s16x4 vl = vtr(vbt + d0 * 4096 + ks2 * 1024), vh = vtr(vbt + d0 * 4096 + ks2 * 1024 + 512);
              const bf16x8 vf = (bf16x8){vl[0], vl[1], vl[2], vl[3], vh[0], vh[1], vh[2], vh[3]};
              o[d0] = __builtin_amdgcn_mfma_f32_32x32x16_bf16(pa, vf, o[d0], 0, 0, 0); } }
    }
    asm volatile("s_waitcnt lgkmcnt(0)" ::: "memory");
#undef AT_FLAG
#undef AT_EDGE
#undef AT_LO
#undef AT_HI
}
template <bool FIRST>
__device__ __forceinline__ void fold_branch(LAS float* outl, const f32x16 (&o)[2], float colfac, LAS float* wsf, int lane) {
    const int r32 = lane & 31, hi = lane >> 5;
    LDS_WAIT(); asm volatile("" ::: "memory");
    if (hi == 0) wsf[r32] = colfac;
    LDS_WAIT(); asm volatile("" ::: "memory");
#pragma unroll
    for (int e = 0; e < 16; ++e) { const int row = crow(e, hi); const float f = wsf[row];
#pragma unroll
        for (int d0 = 0; d0 < 2; ++d0) { LAS float* p = outl + row * 64 + d0 * 32 + r32; if (FIRST) *p = o[d0][e] * f; else *p += o[d0][e] * f; } }
    LDS_WAIT(); asm volatile("" ::: "memory");
}
__device__ __forceinline__ void attn_unit_prompt(const Args& A, LAS unsigned char* lds, int b, int g, int qt, int tid) {
    asm volatile("" : "+v"(tid));
    const int lane = tid & 63, w = tid >> 6, r32 = lane & 31, hi = lane >> 5, ql = r32 >> 2, hh = r32 & 3;
    const int qloc = 8 * w + ql, tq = 64 * qt + qloc; const size_t mrow = (size_t)b * SEQ + tq;
    unsigned char* ws = A.ws;
    LAS float* wsf = (LAS float*)(lds + AT_WSF) + w * 64; LAS float* sA = (LAS float*)(lds + AT_SA); LAS float* sB = (LAS float*)(lds + AT_SB); LAS float* sS = (LAS float*)(lds + AT_SS);
    LAS unsigned char* selb = lds + AT_SEL;
    bf16x8 qf[4];
    { const bf16* qp = (const bf16*)(ws + WS_Q) + mrow * 512 + (g * 4 + hh) * 64 + 8 * hi;
#pragma unroll
      for (int s = 0; s < 4; ++s) qf[s] = *(const GAS bf16x8*)(qp + 16 * s); }
    const float* gp = (const float*)(ws + WS_GATES) + mrow * 32 + g * 12 + hh * 3;
    const float gc = sigmoidf_(gp[0]), gs = sigmoidf_(gp[1]), gw_ = sigmoidf_(gp[2]);
    f32x16 o[2];
#pragma unroll
    for (int e = 0; e < 16; ++e) { o[0][e] = 0.f; o[1][e] = 0.f; }
    LAS float* outl = (LAS float*)(lds + AT_SA) + w * 2048;
    for (int i = tid; i < 2 * 64 * 65; i += 512) sA[i] = 0.f;
    const bf16* Kc = (const bf16*)(ws + WS_KCMP_P) + (size_t)b * 256 * 128 + g * 64; const bf16* Vc = (const bf16*)(ws + WS_VCMP_P) + (size_t)b * 256 * 128 + g * 64;
    const int nct = (4 * qt + 2) / 64 + 1;
    const int nmax = (tq - 31) >> 4;
    SmState Sc{0.f, 0.f, false};
    __syncthreads();
#pragma unroll 1
    for (int ct = 0; ct < nct; ++ct) kv_dma<128>(Kc, Vc, 64 * ct, lds + ct * AT_SLOT, w, lane);
    asm volatile("s_waitcnt vmcnt(0)\n\ts_barrier" ::: "memory");
#pragma unroll 1
    for (int pass = 0; pass < 2; ++pass) {
        float invl = 0.f;
        if (pass == 1) { const float lt = xhalf_sum(Sc.l); invl = lt > 0.f ? 1.0f / lt : 0.f; }
#pragma unroll 1
        for (int ct = 0; ct < nct; ++ct) {
            const LAS unsigned char* buf = lds + ct * AT_SLOT;
            const int hiK = nmax - 64 * ct; const bool full = __all(hiK >= 63);
            if (pass == 0) attn_tile<0>(buf, qf, Sc, o, 0, hiK, full, 0.f, wsf, sA, sB, 0, qloc, lane);
            else attn_tile<1>(buf, qf, Sc, o, 0, hiK, full, invl, wsf, sA, sB, 16 * ct, qloc, lane);
        }
    }
    __syncthreads();
    { const int q = tid >> 3, jj = tid & 7; unsigned key[8]; LAS unsigned* sK = (LAS unsigned*)sS;
#pragma unroll
      for (int e = 0; e < 8; ++e) { const int j = 8 * jj + e; const bool valid = j <= qt, forced = valid && (j == 0 || j == qt || j == qt - 1);
          const float scv = forced ? 1e9f : (valid ? sA[q * 65 + j] + sB[q * 65 + j] : -1e9f);
          unsigned uk = __float_as_uint(scv); uk ^= (uk >> 31) ? 0xFFFFFFFFu : 0x80000000u; key[e] = (uk & ~63u) | (unsigned)(63 - j); sK[q * 64 + j] = key[e]; }
      __syncthreads();
      unsigned rank[8];
#pragma unroll
      for (int e = 0; e < 8; ++e) rank[e] = 0u;
      const int nj4 = (qt < 16) ? 0 : (qt + 4) >> 2;
#pragma unroll 2
      for (int j4 = 0; j4 < nj4; ++j4) { const v4u k4 = *(const LAS v4u*)(sK + q * 64 + 4 * j4);
#pragma unroll
          for (int e = 0; e < 8; ++e) rank[e] += (k4.x > key[e] ? 1u : 0u) + (k4.y > key[e] ? 1u : 0u) + (k4.z > key[e] ? 1u : 0u) + (k4.w > key[e] ? 1u : 0u); }
      unsigned bits = 0u;
#pragma unroll
      for (int e = 0; e < 8; ++e) bits |= (rank[e] < 16u ? 1u : 0u) << e;
      selb[q * 8 + jj] = (unsigned char)bits; }
    __syncthreads();
    const unsigned sel_lo = *(const LAS unsigned*)(selb + qloc * 8), sel_hi = *(const LAS unsigned*)(selb + qloc * 8 + 4);
    __syncthreads();
    fold_branch<true>(outl, o, gc, wsf, lane);
    {
        const bf16* Kg = (const bf16*)(ws + WS_KS) + (size_t)b * SEQ * 256 + g * 64; const bf16* Vg = Kg + 128;
#pragma unroll
        for (int e = 0; e < 16; ++e) { o[0][e] = 0.f; o[1][e] = 0.f; }
        SmState S{0.f, 0.f, false};
        attn_stream<false>(lds, Kg, Vg, 0, qt, sel_lo, sel_hi, qf, S, o, wsf, qloc, w, lane);
        const float lt = xhalf_sum(S.l);
        fold_branch<false>(outl, o, lt > 0.f ? gs / lt : 0.f, wsf, lane);
    }
    {
        const bf16* Kg = (const bf16*)(ws + WS_KW) + (size_t)b * SEQ * 256 + g * 64; const bf16* Vg = Kg + 128;
#pragma unroll
        for (int e = 0; e < 16; ++e) { o[0][e] = 0.f; o[1][e] = 0.f; }
        SmState S{0.f, 0.f, false};
        attn_stream<true>(lds, Kg, Vg, qt >= 8 ? qt - 8 : 0, qt, 0u, 0u, qf, S, o, wsf, qloc, w, lane);
        const float lt = xhalf_sum(S.l);
        fold_branch<false>(outl, o, lt > 0.f ? gw_ / lt : 0.f, wsf, lane);
    }
    { bf16* mix = (bf16*)(ws + WS_MIX);
#pragma unroll
      for (int i = 0; i < 4; ++i) { const int row = i * 8 + (lane >> 3), ch = lane & 7; const f32x4 v0 = *(const LAS f32x4*)(outl + row * 64 + ch * 8), v1 = *(const LAS f32x4*)(outl + row * 64 + ch * 8 + 4);
          const int q2 = row >> 2, h2 = row & 3;
          *(GAS v4u*)(mix + ((size_t)b * SEQ + 64 * qt + 8 * w + q2) * DM + (g * 4 + h2) * 64 + ch * 8) = pack8(v0, v1); }
      LDS_WAIT(); asm volatile("" ::: "memory"); }
    __syncthreads();
}

constexpr int SA_Q = 0, SA_SC = 1024  , SA_PTR = SA_SC + 1024 * 16  , SA_RED = SA_PTR + 1024 * 8, SA_SS = SA_RED + 512, SA_LIST = SA_SS + 264 * 4,
              SA_OACC = SA_LIST + 64  , SA_OUT = SA_OACC + 8 * 256 * 4, SA_END = SA_OUT + 256 * 4;
static_assert(SA_END <= RING_BYTES, "sample attention LDS");
__device__ __forceinline__ void block_max4(float (&v)[4], LAS float* red, int tid) {
#pragma unroll
    for (int h = 0; h < 4; ++h) v[h] = wave_max(v[h]);
    __syncthreads();
    if ((tid & 63) == 0) {
#pragma unroll
        for (int h = 0; h < 4; ++h) red[(tid >> 6) * 4 + h] = v[h]; }
    __syncthreads();
#pragma unroll
    for (int h = 0; h < 4; ++h) { float m = red[h];
#pragma unroll
        for (int w = 1; w < 8; ++w) m = fmaxf(m, red[w * 4 + h]);
        v[h] = m; }
}
__device__ __forceinline__ void block_sum4(float (&v)[4], LAS float* red, int tid) {
#pragma unroll
    for (int h = 0; h < 4; ++h) v[h] = wave_sum(v[h]);
    __syncthreads();
    if ((tid & 63) == 0) {
#pragma unroll
        for (int h = 0; h < 4; ++h) red[(tid >> 6) * 4 + h] = v[h]; }
    __syncthreads();
#pragma unroll
    for (int h = 0; h < 4; ++h) { float m = red[h];
#pragma unroll
        for (int w = 1; w < 8; ++w) m += red[w * 4 + h];
        v[h] = m; }
}
template <class KRow>
__device__ __forceinline__ void sample_branch(LAS unsigned char* lds, int nkeys, const KRow& krow, long voff, const float (&gate)[4], int tid) {
    LAS float* qs = (LAS float*)(lds + SA_Q); LAS f32x4* sc = (LAS f32x4*)(lds + SA_SC); LAS float* red = (LAS float*)(lds + SA_RED);
    typedef const float* cfptr; LAS cfptr* kp = (LAS cfptr*)(lds + SA_PTR); LAS float* oacc = (LAS float*)(lds + SA_OACC); LAS float* OUT = (LAS float*)(lds + SA_OUT);
    float mx[4] = {-INFINITY, -INFINITY, -INFINITY, -INFINITY};
    for (int i = tid; i < 1024; i += 512) {
        float s[4] = {-INFINITY, -INFINITY, -INFINITY, -INFINITY};
        const float* kr = (i < nkeys) ? krow(i) : nullptr;
        kp[i] = kr;
        if (kr) { s[0] = s[1] = s[2] = s[3] = 0.f;
#pragma unroll
            for (int d4 = 0; d4 < 16; ++d4) { const f32x4 kv = *(const GAS f32x4*)(kr + 4 * d4);
#pragma unroll
                for (int h = 0; h < 4; ++h) { const f32x4 q = *(const LAS f32x4*)(qs + h * 64 + 4 * d4); s[h] += (kv[0] * q[0] + kv[1] * q[1]) + (kv[2] * q[2] + kv[3] * q[3]); } } }
        sc[i] = (f32x4){s[0], s[1], s[2], s[3]};
#pragma unroll
        for (int h = 0; h < 4; ++h) mx[h] = fmaxf(mx[h], s[h]);
    }
    block_max4(mx, red, tid);
    float sm[4] = {0.f, 0.f, 0.f, 0.f};
    for (int i = tid; i < 1024; i += 512) { f32x4 v = sc[i];
#pragma unroll
        for (int h = 0; h < 4; ++h) { const float e = (v[h] > -INFINITY && mx[h] > -INFINITY) ? fexp2(v[h] - mx[h]) : 0.f; v[h] = e; sm[h] += e; }
        sc[i] = v; }
    block_sum4(sm, red, tid);
    { f32x4 inv;
#pragma unroll
      for (int h = 0; h < 4; ++h) inv[h] = sm[h] > 0.f ? 1.0f / sm[h] : 0.f;
      for (int i = tid; i < 1024; i += 512) sc[i] = sc[i] * inv; }
    __syncthreads();
    { const int w = tid >> 6, d = tid & 63; f32x4 acc = (f32x4){0.f, 0.f, 0.f, 0.f};
      for (int i0 = w; i0 < nkeys; i0 += 128) { float vv[16]; f32x4 pp[16];
#pragma unroll
          for (int u = 0; u < 16; ++u) { const int i = i0 + 8 * u; const float* kr = (i < nkeys) ? kp[i] : nullptr; pp[u] = (i < nkeys) ? sc[i] : (f32x4){0.f, 0.f, 0.f, 0.f}; vv[u] = kr ? *(const GAS float*)(kr + voff + d) : 0.f; }
#pragma unroll
          for (int u = 0; u < 16; ++u) acc += pp[u] * vv[u]; }
#pragma unroll
      for (int h = 0; h < 4; ++h) oacc[(w * 4 + h) * 64 + d] = acc[h]; }
    __syncthreads();
    if (tid < 256) { const int hq = tid >> 6, d = tid & 63; const float gt = hq == 0 ? gate[0] : hq == 1 ? gate[1] : hq == 2 ? gate[2] : gate[3]; float s = 0.f;
#pragma unroll
        for (int w = 0; w < 8; ++w) s += oacc[(w * 4 + hq) * 64 + d];
        OUT[tid] += gt * s; }
    __syncthreads();
}
__device__ __forceinline__ void attn_unit_sample(const Args& A, LAS unsigned char* lds, int b, int g, int tid) {
    asm volatile("" : "+v"(tid));
    unsigned char* ws = A.ws;
    const float* zs = (const float*)(ws + WS_ZS) + (size_t)b * NIN;
    LAS float* qs = (LAS float*)(lds + SA_Q); LAS f32x4* sc = (LAS f32x4*)(lds + SA_SC); LAS float* ss = (LAS float*)(lds + SA_SS); LAS int* list = (LAS int*)(lds + SA_LIST); LAS float* OUT = (LAS float*)(lds + SA_OUT);
    __syncthreads();
    if (tid < 256) { qs[tid] = zs[g * 256 + tid] * QSCALE; OUT[tid] = 0.f; }
    float gate[3][4];
#pragma unroll
    for (int h = 0; h < 4; ++h)
#pragma unroll
        for (int br = 0; br < 3; ++br) gate[br][h] = sigmoidf_(zs[2304 + g * 12 + h * 3 + br]);
    __syncthreads();
    const int* pt = (const int*)A.in[7] + b * NPAGE;
    { const float* Kc = (const float*)(ws + WS_KCMP_S) + ((size_t)b * 1024 * 2 + g) * 64;
      sample_branch(lds, NBLK_S, [&](int i) { return Kc + (size_t)i * 128; }, (long)((WS_VCMP_S - WS_KCMP_S) / 4), gate[0], tid); }
    if (tid < 264) { float s = -2e9f;
        if (tid < 257) { const int j = tid; float imp[5];
#pragma unroll
            for (int e = 0; e < 5; ++e) { const int n = 4 * j - 1 + e; float v = 0.f; if (n >= 0 && n < NBLK_S) { const f32x4 p = sc[n]; v = (p[0] + p[1]) + (p[2] + p[3]); } imp[e] = v; }
            s = imp[0] + 2.0f * (imp[1] + imp[2] + imp[3]) + imp[4];
            if (j == 0 || j == 255 || j == 256) s = 1e9f; }
        ss[tid] = s; }
    __syncthreads();
    if (tid < 257) { const float s = ss[tid]; int rank = 0;
        for (int j2 = 0; j2 < 257; ++j2) { const float s2 = ss[j2]; rank += (s2 > s || (s2 == s && j2 < tid)) ? 1 : 0; }
        if (rank < 16) list[rank] = tid; }
    __syncthreads();
    { const float* cache = A.in[3]; const float* knew = zs + 768 + g * 64;
      sample_branch(lds, 1024, [&](int i) -> const float* { const int blk = list[i >> 6], pos = blk * 64 + (i & 63);
          if (pos > PAST) return (const float*)nullptr; if (pos == PAST) return knew;
          const int page = pt[pos >> 7]; return cache + (((size_t)page * PAGE + (pos & 127)) * 4 + g) * 64; }, 128L, gate[1], tid); }
    { const float* wb = A.in[4] + (size_t)b * 512 * 256; const float* knew = zs + 1024 + g * 64;
      sample_branch(lds, 512, [&](int i) -> const float* { if (i == 511) return knew; return wb + ((size_t)(i + 1) * 4 + g) * 64; }, 128L, gate[2], tid); }
    if (tid < 256) ((bf16*)(ws + WS_MIXS))[(size_t)b * DM + g * 256 + tid] = (bf16)f2bf(OUT[tid]);
    __syncthreads();
}

constexpr int N_PHASES = 12;
__global__ void __launch_bounds__(NWAVES * 64, 2) nsa_hybrid_fwd(Args args) {
    extern __shared__ __attribute__((aligned(16))) unsigned char lds_raw[];
    LAS unsigned char* lds = (LAS unsigned char*)lds_raw;
    volatile LAS unsigned* MISC = (volatile LAS unsigned*)(lds + MISC_OFF);
    const int wave_s = __builtin_amdgcn_readfirstlane(threadIdx.x >> 6);
    const int G = gridDim.x, bx = blockIdx.x, vcu = (G % 8 == 0) ? (bx % 8) * (G / 8) + bx / 8 : bx;
    gu32* ctl = (gu32*)(args.ws + WS_CTL);
    for (int u = threadIdx.x; u < (LDS_BYTES - LDSCTL_OFF) / 4; u += NWAVES * 64) ((LAS unsigned*)(lds + LDSCTL_OFF))[u] = 0u;
    __syncthreads();
    XcdBarrier bar; bar.bar = (unsigned*)(ctl + CW_BAR); bar.x = 0; bar.st = nullptr;
    if (!MK_PER_PHASE) bar = xcd_barrier_post((unsigned*)(ctl + CW_BAR), MISC + 8);
    const int lo = args.ph_lo, hi = args.ph_hi;
#ifndef PH_MASK
#define PH_MASK 0xFFF
#endif
#define IN(k) (((PH_MASK >> (k)) & 1) && lo <= (k) && (k) < hi)
#define SEAM(k) do { if (IN(k) && IN((k) + 1)) xcd_barrier(bar); if (PROBE_PHASE == (k) + 1) pt0 = rt(); if (PROBE_PHASE == (k)) pt1 = rt(); } while (0)
    unsigned long long pt0 = 0ull, pt1 = 0ull; if (PROBE_PHASE == 0) pt0 = rt();
#define RETID() do { tid = (wave_s << 6) | (int)__builtin_amdgcn_mbcnt_hi(~0u, __builtin_amdgcn_mbcnt_lo(~0u, 0u)); asm volatile("" : "+v"(tid)); } while (0)
#define PHASE_ARGS() const __attribute__((address_space(4))) Args* kp_ = (const __attribute__((address_space(4))) Args*)__builtin_amdgcn_kernarg_segment_ptr(); asm volatile("" : "+s"(kp_)); \
    const Args A = *(const Args*)kp_; unsigned char* const ws = A.ws; float* const rowss = (float*)(ws + WS_ROWSS); \
    bf16* const H0 = (bf16*)(ws + WS_H0); bf16* const XB = (bf16*)(ws + WS_XB); bf16* const XB2 = (bf16*)(ws + WS_XR); float* const XR = (float*)(ws + WS_XR); bf16* const HF = (bf16*)(ws + WS_HF); \
    float* const XRS = (float*)(ws + WS_XRS); bf16* const XBS = (bf16*)(ws + WS_XBS); bf16* const HFS = (bf16*)(ws + WS_HFS); \
    (void)rowss; (void)H0; (void)XB; (void)XB2; (void)XR; (void)HF; (void)XRS; (void)XBS; (void)HFS; \
    int tid = (wave_s << 6) | (int)__builtin_amdgcn_mbcnt_hi(~0u, __builtin_amdgcn_mbcnt_lo(~0u, 0u)); asm volatile("" : "+v"(tid)); const int lane = tid & 63, wave = wave_s; (void)lane; (void)wave;

    if (IN(0)) { PHASE_ARGS(); p0_prologue(A, lds, vcu, G, tid); }
    SEAM(0);
    if (IN(1)) { PHASE_ARGS();
        pg8::Gemm g{H0, (const bf16*)(ws + WS_WIN_T), MP, NIN, DM, DM, 0}; pg8::StaticOrder S; S.init(MP, NIN, G, bx);
        EpiInProj E{(bf16*)(ws + WS_Q), (bf16*)(ws + WS_KS), (bf16*)(ws + WS_KW), (bf16*)(ws + WS_AGLU), (float*)(ws + WS_GATES), A.out};
        pg8::gemm_phase<EpiInProj, pg8::StaticOrder, true, true>(lds, g, S, E); RETID();
        float* ZS = (float*)(ws + WS_ZS);
        skinny_gemm<1>(lds, (const bf16*)(ws + WS_HS0), DM, 0, (const bf16*)(ws + WS_WIN_T), DM, NIN / 16, bx, G, [](int task, int) { return 16 * task; },
            [&](int task, int s, int c, const float (&v)[1]) { ZS[(size_t)s * NIN + 16 * task + c] = v[0]; }, tid);
    }
    SEAM(1);
    if (IN(2)) { PHASE_ARGS();
        const int gw = vcu * NWAVES + wave, NGW = G * NWAVES;
        for (int rep = 0; rep < REP_COMPRESS; ++rep)
        { const int nfull = (586 / G) * G, nrem = 586 - nfull;
          for (int t = vcu; t < nfull; t += G) compress_wgtask(A, lds, t, wave, lane, true);
          for (int s3 = vcu; s3 < 3 * nrem; s3 += G) { const int part = s3 % 3, lo = 3 * part, hi = lo + 3; compress_wgtask(A, lds, nfull + s3 / 3, wave, lane, wave >= lo && wave < hi); } }
        __syncthreads();
        const float* ZS = (const float*)(ws + WS_ZS);
        for (size_t i0 = (size_t)vcu * 512 + tid; i0 < (size_t)SB * 512 * 64; i0 += (size_t)G * 512 * 8) {
            f32x4 v[8];
#pragma unroll
            for (int k = 0; k < 8; ++k) { const size_t i = i0 + (size_t)k * G * 512; const int s = (int)(i >> 15), r = (int)((i >> 6) & 511), c4 = (int)(i & 63);
                if (i < (size_t)SB * 512 * 64) { if (r < 511) v[k] = *(const GAS f32x4*)(A.in[4] + ((size_t)(s * 512 + r + 1) * 256 + 4 * c4)); else v[k] = *(const GAS f32x4*)(ZS + (size_t)s * NIN + 1024 + 4 * c4); } }
#pragma unroll
            for (int k = 0; k < 8; ++k) { const size_t i = i0 + (size_t)k * G * 512; const int s = (int)(i >> 15), r = (int)((i >> 6) & 511), c4 = (int)(i & 63);
                if (i < (size_t)SB * 512 * 64) *(GAS f32x4*)(A.out + O_WIN_S + ((size_t)(s * 512 + r) * 256 + 4 * c4)) = v[k]; } }
        for (int i = vcu * 512 + tid; i < SB * 256; i += G * 512) { const int s = i >> 8, c = i & 255; A.out[O_CMP_S + i] = ZS[(size_t)s * NIN + 512 + c]; A.out[O_SLC_S + i] = ZS[(size_t)s * NIN + 768 + c]; }
    }
    SEAM(2);
    if (IN(3)) { PHASE_ARGS();
        constexpr int QN = 17 + 8 + 128 + 33;
        for (int rep = 0; rep < REP_PROMPT; ++rep) {
        gu32* qctr = (gu32*)(ws + WS_CTL) + CW_Q3 + rep * 512;
        int x = (int)(xb_xcc_id() & 7u);
#pragma unroll 1
        for (;;) {
            __syncthreads();
            if (tid < 64) {
                unsigned it = 0u; if (tid == 0) it = __hip_atomic_fetch_add(qctr + 64 * x, 1u, __ATOMIC_RELAXED, __HIP_MEMORY_SCOPE_AGENT);
                it = (unsigned)__builtin_amdgcn_readfirstlane((int)it);
                int nx = x;
                if (it >= (unsigned)QN) { int t8 = tid; asm volatile("" : "+v"(t8));
                    const unsigned c = (t8 < 8) ? __hip_atomic_load(qctr + 64 * t8, __ATOMIC_RELAXED, __HIP_MEMORY_SCOPE_AGENT) : 0xffffffffu;
                    const unsigned long long open = __ballot(c < (unsigned)QN);
                    nx = open ? (int)__builtin_ctzll(open) : -1; }
                if (tid == 0) { MISC[16] = it; MISC[17] = (unsigned)nx; }
            }
            __syncthreads();
            const int it = __builtin_amdgcn_readfirstlane((int)MISC[16]), nx = __builtin_amdgcn_readfirstlane((int)MISC[17]);
            if (it >= QN) { if (nx < 0) break; x = nx; continue; }
            if (it < 17) {
#pragma unroll 1
                for (int k = 0; k < 4; ++k) { const int idx = (((x * 17 + it) << 3) + wave) * 4 + k; if (idx < 4224) ffn_weight_item(A, idx, lane); } }
            else if (it < 25) { const int idx = 8 * x + (it - 17); attn_unit_sample(A, lds, idx >> 1, idx & 1, tid); }
            else if (it < 153) { const int j = it - 25, bg = 2 * x + (j & 1); attn_unit_prompt(A, lds, bg >> 1, bg & 1, 63 - (j >> 1), tid); }
            else { const int c = it - 154;
#pragma unroll 1
                for (int k = 0; k < 4; ++k) { if (c >= 0) { if (k < 2) conv_unit_prompt(A, lds, x * 64 + 2 * c + k, tid); } else conv_unit_sample(A, lds, 4 * x + k, tid); } }
        }
        }
    }
    SEAM(3);
    if (IN(4)) { PHASE_ARGS();
        pg8::Gemm g{(const bf16*)(ws + WS_MIX), (const bf16*)(ws + WS_WOUT_T), MP, DM, DM, DM, 0}; pg8::StaticOrder S; S.init(MP, DM, G, bx);
        EpiRes<true, false> E{A.in[0], XB, nullptr, rowss + 0 * RS_STRIDE};
        pg8::gemm_phase<EpiRes<true, false>, pg8::StaticOrder, true, true>(lds, g, S, E); RETID();
        const float* xs = A.in[1]; float* rs = rowss + 0 * RS_STRIDE + MP;
        const int es_ = 16 * (tid >> 8) + (((tid >> 2) & 63) >> 4) * 4 + (tid & 3), ec_ = (tid >> 2) & 15;
        float xpre = 0.f; if (bx < DM / 16) xpre = xs[(size_t)es_ * DM + 16 * bx + ec_];
        skinny_gemm<1>(lds, (const bf16*)(ws + WS_MIXS), DM, 0, (const bf16*)(ws + WS_WOUT_T), DM, DM / 16, bx, G, [](int task, int) { return 16 * task; },
            [&](int task, int s, int c, const float (&v)[1]) { const size_t o = (size_t)s * DM + 16 * task + c; const float x1 = (task == bx ? xpre : xs[o]) + v[0]; XRS[o] = x1; XBS[o] = (bf16)f2bf(x1); skinny_rowss(x1 * x1, rs, s, tid); }, tid);
    }
    SEAM(4);
#define FFN_PHASES(L, PGU, PDN, RS_IN, RS_OUT, XBUF) \
    if (IN(PGU)) { PHASE_ARGS(); \
        pg8::Gemm g{XBUF, (const bf16*)(ws + WS_WGU_T + (L) * WGU_BYTES), MP, NGU, DM, DM, 0}; pg8::StaticOrder S; S.init(MP, NGU, G, bx); \
        EpiGateUp E{HF, rowss + (RS_IN) * RS_STRIDE}; \
        pg8::gemm_phase<EpiGateUp, pg8::StaticOrder, true, true>(lds, g, S, E); RETID(); \
        const float* rs = rowss + (RS_IN) * RS_STRIDE + MP; \
        const int es_ = 16 * (tid >> 8) + (((tid >> 2) & 63) >> 4) * 4 + (tid & 3); const float rspre = rs[es_];     \
        skinny_gemm<2>(lds, XBS, DM, 0, (const bf16*)(ws + WS_WGU_T + (L) * WGU_BYTES), DM, FF / 16, bx, G, [](int task, int j) { return 256 * ((16 * task) >> 7) + ((16 * task) & 127) + 128 * j; }, \
            [&](int task, int s, int c, const float (&v)[2]) { const float rstd = 1.0f / sqrtf(rspre * (1.0f / DM) + EPS); const float gg = v[0] * rstd, uu = v[1] * rstd; \
                HFS[(size_t)s * FF + 16 * task + c] = (bf16)f2bf(gg * sigmoidf_(gg) * uu); }, tid); \
    } \
    SEAM(PGU); \
    if (IN(PDN)) { PHASE_ARGS(); \
        pg8::Gemm g{HF, (const bf16*)(ws + WS_WD_T + (L) * WD_BYTES), MP, DM, FF, FF, 0}; pg8::StaticOrder S; S.init(MP, DM, G, bx); \
        EpiRes<false, false> E{nullptr, XBUF, nullptr, rowss + (RS_OUT) * RS_STRIDE}; \
        pg8::gemm_phase<EpiRes<false, false>, pg8::StaticOrder, true, true>(lds, g, S, E); RETID(); \
        float* rs = rowss + (RS_OUT) * RS_STRIDE + MP; \
        const int es_ = 16 * (tid >> 8) + (((tid >> 2) & 63) >> 4) * 4 + (tid & 3), ec_ = (tid >> 2) & 15; \
        float xpre = 0.f; if (bx < DM / 16) xpre = XRS[(size_t)es_ * DM + 16 * bx + ec_];                         \
        skinny_gemm<1>(lds, HFS, FF, 0, (const bf16*)(ws + WS_WD_T + (L) * WD_BYTES), FF, DM / 16, bx, G, [](int task, int) { return 16 * task; }, \
            [&](int task, int s, int c, const float (&v)[1]) { const size_t o = (size_t)s * DM + 16 * task + c; const float x2 = (task == bx ? xpre : XRS[o]) + v[0]; XRS[o] = x2; skinny_rowss(x2 * x2, rs, s, tid); }, tid); \
    } \
    SEAM(PDN);
    FFN_PHASES(0, 5, 6, 0, 1, XB)
    if (IN(7)) { PHASE_ARGS();
        for (int u = vcu; u < SB; u += G) pool_prep_sample(A, u, tid);
    }
    SEAM(7);
    if (IN(8)) { PHASE_ARGS();
#pragma unroll 1
        for (int p = bx; p < 256; p += G) pool_fused_wg(A, lds, p & 3, p >> 2, tid);
        float* rs = rowss + 2 * RS_STRIDE + MP; const float* psc = A.in[24];
        const int es_ = 16 * (tid >> 8) + (((tid >> 2) & 63) >> 4) * 4 + (tid & 3), ec_ = (tid >> 2) & 15;
        float xpre = 0.f, ppre = 0.f; if (bx < DM / 16) { xpre = XRS[(size_t)es_ * DM + 16 * bx + ec_]; ppre = psc[16 * bx + ec_]; }
        skinny_gemm<1>(lds, (const bf16*)(ws + WS_ZPS), DM, 256, (const bf16*)(ws + WS_POOL_T), 256, DM / 16, bx, G, [](int task, int) { return 16 * task; },
            [&](int task, int s, int c, const float (&v)[1]) { const int col = 16 * task + c; const size_t o = (size_t)s * DM + col; const float x3 = (task == bx ? xpre + v[0] * ppre : XRS[o] + v[0] * psc[col]); XRS[o] = x3; XBS[o] = (bf16)f2bf(x3); skinny_rowss(x3 * x3, rs, s, tid); }, tid);
    }
    SEAM(8);
    FFN_PHASES(1, 9, 10, 2, 3, XB2)
    if (IN(11)) { PHASE_ARGS();
        const int gw = vcu * NWAVES + wave, NGW = G * NWAVES; const float* rs = rowss + 3 * RS_STRIDE;
        for (int m0 = 4 * gw; m0 < MP; m0 += 4 * NGW) {
            v4u xv[4][2]; float rsv[4];
#pragma unroll
            for (int q = 0; q < 4; ++q) { const GAS v4u* xr = (const GAS v4u*)(XB2 + (size_t)(m0 + q) * DM) + lane; xv[q][0] = xr[0]; xv[q][1] = xr[64]; rsv[q] = *(const GAS float*)(rs + m0 + q); }
            const GAS f32x4* gr = (const GAS f32x4*)A.in[10] + 2 * lane;
            const f32x4 g0 = gr[0], g1 = gr[1], g2 = gr[128], g3 = gr[129];
#pragma unroll
            for (int q = 0; q < 4; ++q) { const float rstd = 1.0f / sqrtf(rsv[q] * (1.0f / DM) + EPS); GAS f32x4* o = (GAS f32x4*)(A.out + O_Y + (size_t)(m0 + q) * DM) + 2 * lane;
                const v4u w0 = xv[q][0], w1 = xv[q][1];
                o[0] = (f32x4){bflo(w0.x), bfhi(w0.x), bflo(w0.y), bfhi(w0.y)} * rstd * g0; o[1] = (f32x4){bflo(w0.z), bfhi(w0.z), bflo(w0.w), bfhi(w0.w)} * rstd * g1;
                o[128] = (f32x4){bflo(w1.x), bfhi(w1.x), bflo(w1.y), bfhi(w1.y)} * rstd * g2; o[129] = (f32x4){bflo(w1.z), bfhi(w1.z), bflo(w1.w), bfhi(w1.w)} * rstd * g3; } }
        if (gw < SB) final_row(XRS + (size_t)gw * DM, rs[MP + gw], A.in[10], A.out + O_YS + (size_t)gw * DM, lane);
    }
#undef IN
#undef SEAM
}

extern "C" void kernel_launch(void* const* d_in, const int* in_sizes, int n_in, void* d_out, int out_size, void* d_ws, size_t ws_size, hipStream_t stream) {
    static int grid = 0;
    if (grid == 0) {
        if (n_in != 28 || (size_t)out_size != O_END || ws_size < WS_END) { fprintf(stderr, "kernel_launch: unexpected shapes: n_in %d out %d ws %zu\n", n_in, out_size, ws_size); grid = -1; return; }
        int dev = 0, cus = 0, per_cu = 0;
        if (hipGetDevice(&dev) != hipSuccess || hipDeviceGetAttribute(&cus, hipDeviceAttributeMultiprocessorCount, dev) != hipSuccess) { grid = -1; return; }
        if (hipFuncSetAttribute((const void*)nsa_hybrid_fwd, hipFuncAttributeMaxDynamicSharedMemorySize, LDS_BYTES) != hipSuccess) { fprintf(stderr, "kernel_launch: hipFuncSetAttribute failed\n"); grid = -1; return; }
        if (hipOccupancyMaxActiveBlocksPerMultiprocessor(&per_cu, (const void*)nsa_hybrid_fwd, NWAVES * 64, LDS_BYTES) != hipSuccess || per_cu < 1)
            fprintf(stderr, "kernel_launch: note: occupancy query reports %d workgroups per CU\n", per_cu);
        (void)hipGetLastError();
        grid = cus;
    }
    if (grid < 0) return;
    if (hipMemsetAsync((char*)d_ws + WS_CTL, 0, CTL_ZERO_BYTES, stream) != hipSuccess) { fprintf(stderr, "kernel_launch: memset failed\n"); return; }
    Args a{};
    for (int i = 0; i < 28; ++i) a.in[i] = (const float*)d_in[i];
    a.out = (float*)d_out; a.ws = (unsigned char*)d_ws;
#if MK_PER_PHASE
    for (int ph = 0; ph < N_PHASES; ++ph) { a.ph_lo = ph; a.ph_hi = ph + 1; for (int rep = 0; rep < ((ph == PROBE_REPEAT) ? 1 + PROBE_NREP : 1); ++rep) hipLaunchKernelGGL(nsa_hybrid_fwd, dim3(grid), dim3(NWAVES * 64), LDS_BYTES, stream, a); }
#else
    a.ph_lo = 0; a.ph_hi = N_PHASES;
    hipLaunchKernelGGL(nsa_hybrid_fwd, dim3(grid), dim3(NWAVES * 64), LDS_BYTES, stream, a);
#endif
    const hipError_t le = hipPeekAtLastError();
    if (le != hipSuccess) fprintf(stderr, "kernel_launch: launch failed: %s\n", hipGetErrorName(le));
}
```
